# Optimizing an MI355X kernel written in HIP

```python
import jax, jax.numpy as jnp
from jax import lax
import numpy as np

D_MODEL = 2048
BATCH = 1
SEQ = 8192
DEPTH = 2

GRID_W = 64
CTX_LEN = 256
MIX_WIDTH = D_MODEL
HEAD_DIM = 128
A_Q_HEADS = (MIX_WIDTH // 2) // HEAD_DIM
A_KV_HEADS = 2
A_GROUP = A_Q_HEADS // A_KV_HEADS
A_Q_DIM = A_Q_HEADS * HEAD_DIM
A_KV_DIM = A_KV_HEADS * HEAD_DIM
WINDOW = 128
BLOCK = 128
ROPE_THETA = 10000.0
AXIS_DIM = HEAD_DIM // 2
ATTN_SCALE = HEAD_DIM ** -0.5
NEG_INF = -1e30
B_GROUPS = 4
B_WIDTH = MIX_WIDTH // 2
B_GROUP_DIM = B_WIDTH // B_GROUPS
POOL_WINDOWS = (2, 4, 8, 16)
AB_IN = A_Q_DIM + 2 * A_KV_DIM + B_WIDTH
C_WIDTH = MIX_WIDTH // 2
C_GROUPS = 4
C_GROUP_DIM = C_WIDTH // C_GROUPS
CHUNK = 128
D_WIDTH = MIX_WIDTH - C_WIDTH
D_GROUPS = 8
D_GROUP_DIM = D_WIDTH // D_GROUPS
CD_IN = 2 * C_WIDTH + D_WIDTH
D_FF = ((8 * D_MODEL // 3 + 255) // 256) * 256
N_EVEN = (DEPTH + 1) // 2
N_ODD = DEPTH // 2
EPS = 1e-6

kernel_name = "hybrid_diffusion_window_pool_gmlp_fourier"


def _rms(x, g):
    xf = x.astype(jnp.float32)
    y = xf * lax.rsqrt(jnp.mean(xf * xf, axis=-1, keepdims=True) + EPS)
    return (y * g.astype(jnp.float32)).astype(x.dtype)


def _modulate(h, shift, scale):
    return h * (1 + scale) + shift


def _axial_angles(n):
    rows = n // GRID_W
    row = jnp.repeat(jnp.arange(rows, dtype=jnp.float32), GRID_W)
    col = jnp.tile(jnp.arange(GRID_W, dtype=jnp.float32), rows)
    inv = ROPE_THETA ** (-jnp.arange(0, AXIS_DIM, 2, dtype=jnp.float32) / AXIS_DIM)
    return row[:, None] * inv[None, :], col[:, None] * inv[None, :]


def _rope_half(x, ang):
    x1, x2 = jnp.split(x, 2, axis=-1)
    cos = jnp.cos(ang)[:, None, :]
    sin = jnp.sin(ang)[:, None, :]
    return jnp.concatenate([x1 * cos - x2 * sin, x2 * cos + x1 * sin], axis=-1)


def _rope_2d(x, ang_r, ang_c):
    xf = x.astype(jnp.float32)
    xr, xc = jnp.split(xf, 2, axis=-1)
    return jnp.concatenate([_rope_half(xr, ang_r), _rope_half(xc, ang_c)], axis=-1).astype(x.dtype)


def _window_attention(q, k, v, kc, vc, sink):
    B, N = q.shape[0], q.shape[1]
    nb = N // BLOCK
    L = kc.shape[1]
    qb = q.reshape(B, nb, BLOCK, A_KV_HEADS, A_GROUP, HEAD_DIM)

    def band(t):
        tp = jnp.pad(t, ((0, 0), (BLOCK, BLOCK), (0, 0), (0, 0))).reshape(B, nb + 2, BLOCK, A_KV_HEADS, HEAD_DIM)
        return jnp.concatenate([tp[:, :-2], tp[:, 1:-1], tp[:, 2:]], axis=2)

    kw, vw = band(k), band(v)
    qpos = jnp.arange(N).reshape(nb, BLOCK)
    kpos = (jnp.arange(nb)[:, None] - 1) * BLOCK + jnp.arange(3 * BLOCK)[None, :]
    valid = ((jnp.abs(qpos[:, :, None] - kpos[:, None, :]) <= WINDOW)
             & (kpos[:, None, :] >= 0) & (kpos[:, None, :] < N))
    s_band = jnp.einsum('bnqhgd,bnkhd->bnhgqk', qb, kw).astype(jnp.float32) * ATTN_SCALE
    s_band = jnp.where(valid[None, :, None, None], s_band, NEG_INF)
    s_ctx = jnp.einsum('bnqhgd,blhd->bnhgql', qb, kc).astype(jnp.float32) * ATTN_SCALE
    s_sink = jnp.broadcast_to(sink.astype(jnp.float32).reshape(1, 1, A_KV_HEADS, A_GROUP, 1, 1),
                              (B, nb, A_KV_HEADS, A_GROUP, BLOCK, 1))
    pr = jax.nn.softmax(jnp.concatenate([s_band, s_ctx, s_sink], axis=-1), axis=-1).astype(v.dtype)
    o = (jnp.einsum('bnhgqk,bnkhd->bnqhgd', pr[..., :3 * BLOCK], vw)
         + jnp.einsum('bnhgql,blhd->bnqhgd', pr[..., 3 * BLOCK:3 * BLOCK + L], vc))
    return o.reshape(B, N, A_Q_DIM)


def _ctx_attention(q, k, v, sink):
    B, L = q.shape[0], q.shape[1]
    qg = q.reshape(B, L, A_KV_HEADS, A_GROUP, HEAD_DIM)
    s = jnp.einsum('blhgd,bmhd->bhglm', qg, k).astype(jnp.float32) * ATTN_SCALE
    s_sink = jnp.broadcast_to(sink.astype(jnp.float32).reshape(1, A_KV_HEADS, A_GROUP, 1, 1),
                              (B, A_KV_HEADS, A_GROUP, L, 1))
    pr = jax.nn.softmax(jnp.concatenate([s, s_sink], axis=-1), axis=-1)[..., :L].astype(v.dtype)
    o = jnp.einsum('bhglm,bmhd->blhgd', pr, v)
    return o.reshape(B, L, A_Q_DIM)


def _pool_mix(z, w_pool, pool_scale):
    B, N = z.shape[0], z.shape[1]
    zf = z.astype(jnp.float32)
    cs = jnp.concatenate([jnp.zeros((B, 1, B_WIDTH), jnp.float32), jnp.cumsum(zf, axis=1)], axis=1)
    cs = cs.reshape(B, N + 1, B_GROUPS, B_GROUP_DIM)
    t = jnp.arange(N)
    half = jnp.array(POOL_WINDOWS, dtype=jnp.int32) // 2
    lo = jnp.clip(t[:, None] - half[None, :], 0, N)
    hi = jnp.clip(t[:, None] + half[None, :], 0, N)
    gidx = jnp.arange(B_GROUPS)[None, :]
    mean = (cs[:, hi, gidx] - cs[:, lo, gidx]) / (hi - lo).astype(jnp.float32)[None, :, :, None]
    d = (mean - zf.reshape(B, N, B_GROUPS, B_GROUP_DIM)).astype(z.dtype)
    y = jnp.einsum('bngc,gcd->bngd', d, w_pool).reshape(B, N, B_WIDTH)
    return y * pool_scale


def _even_mix(h, hc, ang_r, ang_c, w_in, qn_g, kn_g, sink, w_pool, pool_scale, w_out, need_ctx):
    B, N = h.shape[0], h.shape[1]
    L = hc.shape[1]
    p = h @ w_in
    q = _rms(p[..., :A_Q_DIM].reshape(B, N, A_Q_HEADS, HEAD_DIM), qn_g)
    k = _rms(p[..., A_Q_DIM:A_Q_DIM + A_KV_DIM].reshape(B, N, A_KV_HEADS, HEAD_DIM), kn_g)
    v = p[..., A_Q_DIM + A_KV_DIM:A_Q_DIM + 2 * A_KV_DIM].reshape(B, N, A_KV_HEADS, HEAD_DIM)
    q = _rope_2d(q, ang_r, ang_c)
    k = _rope_2d(k, ang_r, ang_c)
    pkv = hc @ w_in[:, A_Q_DIM:A_Q_DIM + 2 * A_KV_DIM]
    kc = _rms(pkv[..., :A_KV_DIM].reshape(B, L, A_KV_HEADS, HEAD_DIM), kn_g)
    vc = pkv[..., A_KV_DIM:].reshape(B, L, A_KV_HEADS, HEAD_DIM)
    y = jnp.concatenate([_window_attention(q, k, v, kc, vc, sink),
                         _pool_mix(p[..., A_Q_DIM + 2 * A_KV_DIM:], w_pool, pool_scale)], axis=-1) @ w_out
    if not need_ctx:
        return y, None
    qc = _rms((hc @ w_in[:, :A_Q_DIM]).reshape(B, L, A_Q_HEADS, HEAD_DIM), qn_g)
    yc = jnp.concatenate([_ctx_attention(qc, kc, vc, sink),
                          _pool_mix(hc @ w_in[:, A_Q_DIM + 2 * A_KV_DIM:], w_pool, pool_scale)], axis=-1) @ w_out
    return y, yc


def _fourier_mix(f, w_fourier):
    B, N = f.shape[0], f.shape[1]
    fg = f.astype(jnp.float32).reshape(B, N, D_GROUPS, D_GROUP_DIM)
    z = jnp.fft.fftn(fg, axes=(1, 3), norm='ortho').real.astype(f.dtype)
    return z.reshape(B, N, D_WIDTH) @ w_fourier


def _odd_mix(h, w_in, v_norm_g, w_spatial, b_spatial, w_fourier, w_out):
    B, N = h.shape[0], h.shape[1]
    nc = N // CHUNK
    p = h @ w_in
    u = jax.nn.gelu(p[..., :C_WIDTH], approximate=False)
    v = _rms(jax.nn.gelu(p[..., C_WIDTH:2 * C_WIDTH], approximate=False), v_norm_g)
    vc = v.reshape(B, nc, CHUNK, C_GROUPS, C_GROUP_DIM)
    s = jnp.einsum('gpq,bkqgc->bkpgc', w_spatial, vc) + b_spatial.T[:, :, None]
    c_out = u * s.reshape(B, N, C_WIDTH)
    d_out = _fourier_mix(p[..., 2 * C_WIDTH:], w_fourier)
    return jnp.concatenate([c_out, d_out], axis=-1) @ w_out


def _dwconv3(u, w, b):
    up = jnp.pad(u, ((0, 0), (1, 1), (0, 0)))
    return up[:, :-2] * w[0] + up[:, 1:-1] * w[1] + up[:, 2:] * w[2] + b


def _conv_ffn(h, w_up, conv_w, conv_b, w_down):
    u = _dwconv3(h @ w_up, conv_w, conv_b)
    g, val = jnp.split(u, 2, axis=-1)
    return (jax.nn.silu(g) * val) @ w_down


def setup_inputs(seed: int = 0) -> dict:
    key = jax.random.key(seed)
    ks = iter(jax.random.split(key, 32))

    def nrm(shape, scale):
        return jax.random.normal(next(ks), shape, jnp.float32) * scale

    def gain(shape):
        return 1.0 + nrm(shape, 0.02)

    return {
        'x': nrm((BATCH, SEQ, D_MODEL), 1.0),
        'c': nrm((BATCH, D_MODEL), 1.0),
        'ctx': nrm((BATCH, CTX_LEN, D_MODEL), 1.0),
        'c_ctx': nrm((D_MODEL,), 1.0),
        'w_mod': nrm((DEPTH, D_MODEL, 6 * D_MODEL), D_MODEL ** -0.5),
        'b_mod': nrm((DEPTH, 6 * D_MODEL), 0.02),
        'norm1_g': gain((DEPTH, D_MODEL)),
        'norm2_g': gain((DEPTH, D_MODEL)),
        'ab_w_in': nrm((N_EVEN, D_MODEL, AB_IN), D_MODEL ** -0.5),
        'a_q_norm_g': gain((N_EVEN, HEAD_DIM)),
        'a_k_norm_g': gain((N_EVEN, HEAD_DIM)),
        'a_sink': nrm((N_EVEN, A_Q_HEADS), 0.5),
        'b_w_pool': nrm((N_EVEN, B_GROUPS, B_GROUP_DIM, B_GROUP_DIM), B_GROUP_DIM ** -0.5),
        'b_pool_scale': gain((N_EVEN, B_WIDTH)),
        'ab_w_out': nrm((N_EVEN, MIX_WIDTH, D_MODEL), MIX_WIDTH ** -0.5),
        'cd_w_in': nrm((N_ODD, D_MODEL, CD_IN), D_MODEL ** -0.5),
        'c_v_norm_g': gain((N_ODD, C_WIDTH)),
        'c_w_spatial': nrm((N_ODD, C_GROUPS, CHUNK, CHUNK), CHUNK ** -0.5),
        'c_b_spatial': gain((N_ODD, C_GROUPS, CHUNK)),
        'd_w_fourier': nrm((N_ODD, D_WIDTH, D_WIDTH), D_WIDTH ** -0.5),
        'cd_w_out': nrm((N_ODD, MIX_WIDTH, D_MODEL), MIX_WIDTH ** -0.5),
        'f_w_up': nrm((DEPTH, D_MODEL, 2 * D_FF), D_MODEL ** -0.5),
        'f_conv_w': nrm((DEPTH, 3, 2 * D_FF), 3 ** -0.5),
        'f_conv_b': nrm((DEPTH, 2 * D_FF), 0.02),
        'f_w_down': nrm((DEPTH, D_FF, D_MODEL), D_FF ** -0.5),
    }


def reference(x, c, ctx, c_ctx, w_mod, b_mod, norm1_g, norm2_g, ab_w_in, a_q_norm_g, a_k_norm_g, a_sink,
              b_w_pool, b_pool_scale, ab_w_out, cd_w_in, c_v_norm_g, c_w_spatial, c_b_spatial, d_w_fourier,
              cd_w_out, f_w_up, f_conv_w, f_conv_b, f_w_down):
    ang_r, ang_c = _axial_angles(x.shape[1])
    for layer in range(DEPTH):
        need_ctx = layer < DEPTH - 1
        is_even = layer % 2 == 0
        i = layer // 2
        mod = jax.nn.silu(c) @ w_mod[layer] + b_mod[layer]
        ml = jnp.split(mod[:, None, :], 6, axis=-1)
        mod_c = jax.nn.silu(c_ctx) @ w_mod[layer] + b_mod[layer]
        mc = jnp.split(mod_c[None, None, :], 6, axis=-1)
        h = _modulate(_rms(x, norm1_g[layer]), ml[0], ml[1])
        if is_even:
            hc = _modulate(_rms(ctx, norm1_g[layer]), mc[0], mc[1])
            y, yc = _even_mix(h, hc, ang_r, ang_c, ab_w_in[i], a_q_norm_g[i], a_k_norm_g[i], a_sink[i],
                              b_w_pool[i], b_pool_scale[i], ab_w_out[i], need_ctx)
        else:
            y = _odd_mix(h, cd_w_in[i], c_v_norm_g[i], c_w_spatial[i], c_b_spatial[i], d_w_fourier[i], cd_w_out[i])
            if need_ctx:
                hc = _modulate(_rms(ctx, norm1_g[layer]), mc[0], mc[1])
                yc = _odd_mix(hc, cd_w_in[i], c_v_norm_g[i], c_w_spatial[i], c_b_spatial[i], d_w_fourier[i], cd_w_out[i])
        x = x + ml[2] * y
        x = x + ml[5] * _conv_ffn(_modulate(_rms(x, norm2_g[layer]), ml[3], ml[4]),
                                  f_w_up[layer], f_conv_w[layer], f_conv_b[layer], f_w_down[layer])
        if need_ctx:
            ctx = ctx + mc[2] * yc
            ctx = ctx + mc[5] * _conv_ffn(_modulate(_rms(ctx, norm2_g[layer]), mc[3], mc[4]),
                                          f_w_up[layer], f_conv_w[layer], f_conv_b[layer], f_w_down[layer])
    return x
```

```cpp
#include <hip/hip_runtime.h>
#include <hip/hip_cooperative_groups.h>
#include <cstdio>
#include <cstdint>
namespace cg = cooperative_groups;

#define LAS __attribute__((address_space(3)))
typedef unsigned short bf16_t;
typedef short bf16x8 __attribute__((ext_vector_type(8)));
typedef short s16x4 __attribute__((ext_vector_type(4)));
typedef float f32x4 __attribute__((ext_vector_type(4)));
typedef float f32x2 __attribute__((ext_vector_type(2)));
typedef unsigned u32x4 __attribute__((ext_vector_type(4)));
typedef unsigned u32x2 __attribute__((ext_vector_type(2)));

constexpr int NT = 8192, DM = 2048, LC = 256, MR = NT + LC;
constexpr int FF = 5632, FF2 = 11264;
constexpr float EPS = 1e-6f;
constexpr size_t MiB = 1u << 20;
constexpr size_t WS_CTL = 0, CTL_BYTES = 1 * MiB;
constexpr size_t WS_W_IN0 = 2 * MiB, WS_W_OUT0X = 12 * MiB, WS_W_OB0 = 20 * MiB, WS_W_POOL = 24 * MiB, WS_W_IN1 = 25 * MiB,
                 WS_W_OUT1X = 37 * MiB, WS_W_OB1 = 49 * MiB, WS_W_FO = 53 * MiB, WS_W_UP0 = 55 * MiB, WS_W_UP1 = 99 * MiB,
                 WS_W_DN0 = 143 * MiB, WS_W_DN1 = 165 * MiB, WS_W_SPBD = 187 * MiB, WS_W_CHD = 188 * MiB,
                 WS_W_A1 = 188 * MiB + 65536, WS_W_A2 = 188 * MiB + 262144, WS_TW = 188 * MiB + 524288;
constexpr size_t WS_H = 190 * MiB, WS_QB = 223 * MiB, WS_KB = 239 * MiB, WS_VT = 244 * MiB, WS_ZB = 249 * MiB, WS_CAT = 265 * MiB,
                 WS_U = 313 * MiB, WS_ACT = 489 * MiB, WS_YP = 313 * MiB  ,
                 WS_U1 = 577 * MiB, WS_GV = 593 * MiB, WS_PF = 609 * MiB, WS_VTN = 625 * MiB, WS_GT2 = 641 * MiB, WS_END = 673 * MiB;

enum { PH_PREP = 0, PH_NORM_A0, PH_G_IN0, PH_QKPOOL, PH_ATTN, PH_G_OUT0, PH_NORM_B0, PH_G_UP0, PH_CONV0, PH_G_DN0,
       PH_NORM_A1, PH_G_IN1, PH_G_F1, PH_G_S1, PH_G_S2, PH_G_OUT1, PH_NORM_B1, PH_G_UP1, PH_CONV1, PH_G_DN1, PH_COUNT };

constexpr int PH_REP[20] = {1, 1, 1, 1, 1, 1, 1, 1, 1, 1, 1, 1, 1, 1, 1, 1, 1, 1, 1, 1};
struct Args { const float* in[25]; float* out; unsigned char* ws; int ph_lo, ph_hi; };

struct Ctx {
    const __attribute__((address_space(4))) Args* ap; float* out; unsigned char* ws;
    int tid, lane, wave, G, bid, rep;
};
#define FIN(i) (F.ap->in[i])

__device__ __forceinline__ unsigned cvt_pk_bf16(float lo, float hi) { unsigned r; asm volatile("v_cvt_pk_bf16_f32 %0, %1, %2" : "=v"(r) : "v"(lo), "v"(hi)); return r; }
__device__ __forceinline__ float bf2f(bf16_t b) { return __uint_as_float(((unsigned)b) << 16); }
__device__ __forceinline__ float bflo(unsigned w) { return __uint_as_float(w << 16); }
__device__ __forceinline__ float bfhi(unsigned w) { return __uint_as_float(w & 0xffff0000u); }
__device__ __forceinline__ bf16_t f2bf(float f) { return (bf16_t)(cvt_pk_bf16(f, 0.f) & 0xffffu); }
__device__ __forceinline__ float wave_sum(float v) {
#pragma unroll
    for (int o = 1; o < 64; o <<= 1) v += __shfl_xor(v, o);
    return v;
}
__device__ __forceinline__ f32x2 gelu_pk(f32x2 v) {
    const f32x2 av = __builtin_elementwise_abs(v), d = av * 0.2316418882f + 1.0f;
    f32x2 t; t.x = __builtin_amdgcn_rcpf(d.x); t.y = __builtin_amdgcn_rcpf(d.y);
    f32x2 q = t * 0.5307027145f + (-0.7265760135f); q = q * t + 0.7107068705f; q = q * t + (-0.142248368f); q = q * t + 0.127414796f; q = q * t;
    const f32x2 s = (v * v) * (-0.72134752044f);
    f32x2 e; e.x = __builtin_amdgcn_exp2f(s.x); e.y = __builtin_amdgcn_exp2f(s.y);
    const f32x2 m = v * (q * e), r = v - m;
    f32x2 o; o.x = v.x < 0.f ? m.x : r.x; o.y = v.y < 0.f ? m.y : r.y; return o;
}

constexpr int BM = 256, BK = 64, HALF = 128, HTB = HALF * BK * 2, STAGE_BYTES = 8 * HTB, NXCD = 8, WGM = 8;
__device__ __forceinline__ int lds_byte(int r, int c) { const int st = (r >> 4) * 2 + (c >> 5), rr = r & 15, cc = c & 31, ob = rr * 64 + cc * 2; return st * 1024 + (ob ^ (((ob >> 9) & 1) << 5)); }
__device__ __forceinline__ void stage_rc(int b, int& R, int& C) { const int st = b / 1024, sb = b % 1024, swz = sb ^ (((sb >> 9) & 1) << 5); R = (st >> 1) * 16 + swz / 64; C = (st & 1) * 32 + (swz % 64) / 2; }
__device__ __forceinline__ int perm32(int rho) { const int n = rho >> 4, i = rho & 15; return 8 * (i >> 2) + 4 * n + (i & 3); }

struct GU { const char* A; const char* B; unsigned lda2, ldb2; int nt; int perm; unsigned hA, hB; };
enum { EK_BF16 = 0, EK_RES = 1, EK_GATE = 2, EK_TW = 3, EK_Z2 = 4 };
struct EP { int kind; bf16_t* O; unsigned ldc; unsigned hoff; int gelu; unsigned dup; unsigned choff; const float* base; float* outf; const float* vec; const bf16_t* U1p; const float* bias; };

__device__ __forceinline__ void tile_order(int L, int nM, int nN, int& pm, int& pn) {
    const int nwg = nM * nN; int wgid = L;
    { const int q = nwg / NXCD, r = nwg % NXCD, xcd = wgid % NXCD, off = wgid / NXCD; wgid = (xcd < r ? xcd * (q + 1) : r * (q + 1) + (xcd - r) * q) + off; }
    const int nig = WGM * nN, gid = wgid / nig, fm = gid * WGM, gsz = (nM - fm) < WGM ? (nM - fm) : WGM;
    pm = fm + ((wgid % nig) % gsz); pn = (wgid % nig) / gsz;
}

__device__ __forceinline__ int gemm_units(int ph) {
    switch (ph) {
        case PH_G_IN0: return 386;
        case PH_G_OUT0: return 256;
        case PH_G_UP0: case PH_G_UP1: return 32 * 44;
        case PH_G_DN0: case PH_G_DN1: return 256;
        case PH_G_IN1: return 384;
        case PH_G_F1: return 256;
        case PH_G_S1: return 256;
        case PH_G_S2: return 256;
        case PH_G_OUT1: return 256;
    }
    return 0;
}

__device__ __forceinline__ void unit_desc(const Ctx& F, int ph, int L, GU& u, EP& e) {
    unsigned char* ws = F.ws;
    e.kind = EK_BF16; e.O = nullptr; e.ldc = 0; e.hoff = 0; e.gelu = 0; e.dup = 0; e.choff = 128; u.hA = 0; u.hB = 0; e.base = nullptr; e.outf = nullptr; e.vec = nullptr; e.U1p = nullptr; e.bias = nullptr;
    u.perm = 1;
    const bf16_t* H = (const bf16_t*)(ws + WS_H);
    switch (ph) {
    case PH_G_IN0: {
        const bf16_t* W = (const bf16_t*)(ws + WS_W_IN0);
        u.lda2 = DM * 2; u.ldb2 = DM * 2; u.nt = DM / BK;
        if (L < 322) {
            int pm, pn;
            if (L < 320) tile_order(L, 32, 10, pm, pn); else { pm = 32; pn = 4 + (L - 320); }
            if (pn == 5) {
                u.A = (const char*)(W + (size_t)1280 * DM); u.B = (const char*)(H + (size_t)pm * 256 * DM);
                e.O = (bf16_t*)(ws + WS_VT) + pm * 256; e.ldc = MR;
            } else {
                u.A = (const char*)(H + (size_t)pm * 256 * DM); u.B = (const char*)(W + (size_t)pn * 256 * DM);
                if (pn < 4) { e.O = (bf16_t*)(ws + WS_QB) + (size_t)pm * 256 * 1024 + pn * 256; e.ldc = 1024; }
                else if (pn == 4) { e.O = (bf16_t*)(ws + WS_KB) + (size_t)pm * 256 * 256; e.ldc = 256; }
                else { e.O = (bf16_t*)(ws + WS_ZB) + (size_t)pm * 256 * 1024 + (pn - 6) * 256; e.ldc = 1024; }
            }
        } else if (L < 354) {
            const int f = L - 322, mo = f >> 2, g = f & 3;
            u.A = (const char*)((const bf16_t*)(ws + WS_W_OB0) + (size_t)mo * 256 * 1024 + g * 256); u.lda2 = 1024 * 2;
            u.B = (const char*)((const bf16_t*)(ws + WS_W_POOL) + (size_t)g * 65536); u.ldb2 = 256 * 2; u.nt = 4;
            e.O = (bf16_t*)(ws + WS_W_OUT0X) + (size_t)mo * 256 * 2048 + 1024 + g * 256; e.ldc = 2048;
        } else {
            const int f = L - 354, mo = f >> 2, ct = f & 3;
            u.A = (const char*)((const bf16_t*)(ws + WS_W_OB1) + (size_t)mo * 256 * 1024); u.lda2 = 1024 * 2;
            u.B = (const char*)((const bf16_t*)(ws + WS_W_FO) + (size_t)ct * 256 * 1024); u.ldb2 = 1024 * 2; u.nt = 16;
            e.O = (bf16_t*)(ws + WS_W_OUT1X) + (size_t)mo * 256 * 2048 + 1024 + ct * 256; e.ldc = 2048;
        }
        e.hoff = 128u * e.ldc;
    } break;
    case PH_G_OUT0: case PH_G_OUT1: {
        int pm, pn; tile_order(L, 32, 8, pm, pn);
        const int l1 = (ph == PH_G_OUT1); const int kd = 2048;
        u.A = (const char*)((const bf16_t*)(ws + WS_CAT) + (size_t)pm * 256 * kd); u.lda2 = kd * 2;
        u.B = (const char*)((const bf16_t*)(ws + (l1 ? WS_W_OUT1X : WS_W_OUT0X)) + (size_t)pn * 256 * kd); u.ldb2 = kd * 2; u.nt = kd / BK; u.perm = 0;
        e.kind = EK_RES; e.base = (l1 ? (const float*)F.out : FIN(0)) + (size_t)pm * 256 * DM + pn * 256; e.outf = F.out + (size_t)pm * 256 * DM + pn * 256;
        e.vec = (const float*)(ws + WS_CTL) + l1 * 12288 + 2 * DM + pn * 256;
    } break;
    case PH_G_UP0: case PH_G_UP1: {
        int pm, pn; tile_order(L, 32, 44, pm, pn);
        u.A = (const char*)(H + (size_t)pm * 256 * DM); u.lda2 = DM * 2;
        u.B = (const char*)((const bf16_t*)(ws + (ph == PH_G_UP1 ? WS_W_UP1 : WS_W_UP0)) + (size_t)pn * 256 * DM); u.ldb2 = DM * 2; u.nt = DM / BK;
        e.O = (bf16_t*)(ws + WS_U) + (size_t)pm * 256 * FF2 + pn * 256; e.ldc = FF2; e.hoff = 128u * FF2;
    } break;
    case PH_G_DN0: case PH_G_DN1: {
        int pm, pn; tile_order(L, 32, 8, pm, pn);
        const int l1 = (ph == PH_G_DN1);
        u.A = (const char*)((const bf16_t*)(ws + WS_ACT) + (size_t)pm * 256 * FF); u.lda2 = FF * 2;
        u.B = (const char*)((const bf16_t*)(ws + (l1 ? WS_W_DN1 : WS_W_DN0)) + (size_t)pn * 256 * FF); u.ldb2 = FF * 2; u.nt = FF / BK; u.perm = 0;
        e.kind = EK_RES; e.base = F.out + (size_t)pm * 256 * DM + pn * 256; e.outf = F.out + (size_t)pm * 256 * DM + pn * 256;
        e.vec = (const float*)(ws + WS_CTL) + l1 * 12288 + 5 * DM + pn * 256;
    } break;
    case PH_G_IN1: {
        int pm, pn; tile_order(L, 32, 12, pm, pn);
        u.A = (const char*)(H + (size_t)pm * 256 * DM); u.lda2 = DM * 2;
        u.B = (const char*)((const bf16_t*)(ws + WS_W_IN1) + (size_t)pn * 256 * DM); u.ldb2 = DM * 2; u.nt = DM / BK;
        const size_t dst = pn < 4 ? WS_U1 : (pn < 8 ? WS_GV : WS_PF);
        e.O = (bf16_t*)(ws + dst) + (size_t)pm * 256 * 1024 + (pn & 3) * 256; e.ldc = 1024; e.hoff = 128u * 1024; e.gelu = pn < 8;
    } break;
    case PH_G_F1: {
        const int tt = L >> 3, g = L & 7, a0 = 2 * tt;
        u.A = (const char*)(ws + WS_W_CHD); u.lda2 = 128 * 2;
        u.B = (const char*)((const bf16_t*)(ws + WS_PF) + (size_t)a0 * 1024 + g * 128); u.ldb2 = 64 * 1024 * 2; u.hB = 1024 * 2; u.nt = 2;
        e.O = (bf16_t*)(ws + WS_GT2) + (size_t)g * 128 * 16384 + a0 * 256; e.ldc = 16384; e.hoff = 128; e.choff = 256;
    } break;
    case PH_G_S1: {
        u.A = (const char*)(ws + WS_W_A1); u.lda2 = 256 * 2;
        u.B = (const char*)((const bf16_t*)(ws + WS_GT2) + (size_t)L * 256 * 256); u.ldb2 = 256 * 2; u.nt = 4;
        e.kind = EK_TW; e.O = (bf16_t*)(ws + WS_YP) + (size_t)(L * 4) * 16384; e.bias = (const float*)(ws + WS_TW);
    } break;
    case PH_G_S2: {
        if (L < 128) {
            const int dq = L >> 2, ct = L & 3;
            u.A = (const char*)(ws + WS_W_A2); u.lda2 = 512 * 2;
            u.B = (const char*)((const bf16_t*)(ws + WS_YP) + (size_t)ct * 256 * 16384 + dq * 512); u.ldb2 = 16384 * 2; u.nt = 8;
            e.kind = EK_Z2; e.O = (bf16_t*)(ws + WS_CAT) + (size_t)(4 * dq) * 2048 + 1024 + ct * 256; e.ldc = 2048;
        } else {
            const int f = L - 128, kp = f >> 2, g = f & 3;
            u.A = (const char*)((const bf16_t*)(ws + WS_W_SPBD) + (size_t)g * 65536); u.lda2 = 256 * 2;
            u.B = (const char*)((const bf16_t*)(ws + WS_VTN) + (size_t)g * 256 * 8192 + kp * 256); u.ldb2 = 8192 * 2; u.nt = 4;
            e.kind = EK_GATE; e.O = (bf16_t*)(ws + WS_CAT) + (size_t)kp * 256 * 2048 + g * 256; e.ldc = 2048; e.hoff = 128u * 2048;
            e.U1p = (const bf16_t*)(ws + WS_U1) + (size_t)kp * 256 * 1024 + g * 256; e.bias = FIN(18) + g * 128;
        }
    } break;
    default: u.A = nullptr; u.B = nullptr; u.lda2 = 0; u.ldb2 = 0; u.nt = 2; break;
    }
    if (u.hA == 0) u.hA = 128u * u.lda2;
    if (u.hB == 0) u.hB = 128u * u.ldb2;
}

constexpr size_t WS_TAB = 1 * MiB;
__device__ __forceinline__ int tab_off(int ph) {
    switch (ph) {
        case PH_G_IN0: return 0; case PH_G_OUT0: return 386; case PH_G_UP0: return 642; case PH_G_DN0: return 2050; case PH_G_IN1: return 2306;
        case PH_G_F1: return 2690; case PH_G_S1: return 2946; case PH_G_S2: return 3202; case PH_G_OUT1: return 3458; case PH_G_UP1: return 3714; case PH_G_DN1: return 5122;
    }
    return 0;
}
constexpr int TAB_UNITS = 5378;
__device__ __forceinline__ void store_rec(unsigned long long* r, const GU& u, const EP& e) {
    r[0] = (unsigned long long)u.A; r[1] = (unsigned long long)u.B; r[2] = (unsigned long long)u.lda2 | ((unsigned long long)u.ldb2 << 32);
    r[3] = (unsigned long long)(unsigned)u.nt | ((unsigned long long)(unsigned)u.perm << 32);
    r[4] = (unsigned long long)(unsigned)e.kind | ((unsigned long long)(unsigned)e.gelu << 32);
    r[5] = e.kind == EK_RES ? (unsigned long long)e.outf : (unsigned long long)e.O;
    r[6] = (unsigned long long)e.ldc | ((unsigned long long)e.hoff << 32);
    r[7] = (unsigned long long)e.dup | ((unsigned long long)e.choff << 32);
    r[10] = (unsigned long long)u.hA | ((unsigned long long)u.hB << 32);
    r[8] = e.kind == EK_RES ? (unsigned long long)e.base : (unsigned long long)e.U1p;
    r[9] = e.kind == EK_RES ? (unsigned long long)e.vec : (unsigned long long)e.bias;
}
__device__ __forceinline__ unsigned ldu(const unsigned* p) { return (unsigned)__builtin_amdgcn_readfirstlane((int)__hip_atomic_load(p, __ATOMIC_RELAXED, __HIP_MEMORY_SCOPE_AGENT)); }
__device__ __forceinline__ unsigned long long ldu64(const unsigned* p) { return (unsigned long long)ldu(p) | ((unsigned long long)ldu(p + 1) << 32); }
__device__ __forceinline__ void load_gu(const unsigned* r, GU& u) {
    u.A = (const char*)ldu64(r); u.B = (const char*)ldu64(r + 2); u.lda2 = ldu(r + 4); u.ldb2 = ldu(r + 5); u.nt = (int)ldu(r + 6); u.perm = (int)ldu(r + 7); u.hA = ldu(r + 20); u.hB = ldu(r + 21);
}
__device__ __forceinline__ void load_ep(const unsigned* r, EP& e) {
    e.kind = (int)ldu(r + 8); e.gelu = (int)ldu(r + 9);
    const unsigned long long p5 = ldu64(r + 10); e.O = (bf16_t*)p5; e.outf = (float*)p5;
    e.ldc = ldu(r + 12); e.hoff = ldu(r + 13); e.dup = ldu(r + 14); e.choff = ldu(r + 15);
    const unsigned long long p8 = ldu64(r + 16), p9 = ldu64(r + 18);
    e.base = (const float*)p8; e.U1p = (const bf16_t*)p8; e.vec = (const float*)p9; e.bias = (const float*)p9;
}

__device__ __forceinline__ bool kind_ok(int ph, int kind) {
    const bool res = (ph == PH_G_OUT0) | (ph == PH_G_OUT1) | (ph == PH_G_DN0) | (ph == PH_G_DN1);
    if (kind == EK_RES) return res;
    if (kind == EK_GATE || kind == EK_Z2) return ph == PH_G_S2;
    if (kind == EK_TW) return ph == PH_G_S1;
    return !res && ph != PH_G_S1 && ph != PH_G_S2;
}
__device__ __forceinline__ void run_epilogue(const Ctx& F, int ph, const EP& e, const f32x4 (&acc)[2][2][4][2], int wr, int wc, int fr, int fq) {
    asm volatile("" : "+v"(fr), "+v"(fq));
    if (kind_ok(ph, EK_BF16)) {
        const unsigned col0 = wc * 32 + 8 * fq;
#pragma unroll
        for (int ai = 0; ai < 2; ++ai)
#pragma unroll
            for (int m = 0; m < 4; ++m) {
                bf16_t* rowp = e.O + (size_t)ai * e.hoff + (size_t)(wr * 64 + m * 16 + fr) * e.ldc + col0;
#pragma unroll
                for (int bj = 0; bj < 2; ++bj) {
                    f32x4 v0 = acc[ai][bj][m][0], v1 = acc[ai][bj][m][1];
                    if (e.gelu) { f32x2 a = gelu_pk((f32x2){v0[0], v0[1]}), b = gelu_pk((f32x2){v0[2], v0[3]}), c = gelu_pk((f32x2){v1[0], v1[1]}), d = gelu_pk((f32x2){v1[2], v1[3]});
                        v0 = (f32x4){a.x, a.y, b.x, b.y}; v1 = (f32x4){c.x, c.y, d.x, d.y}; }
                    u32x4 w; w.x = cvt_pk_bf16(v0[0], v0[1]); w.y = cvt_pk_bf16(v0[2], v0[3]); w.z = cvt_pk_bf16(v1[0], v1[1]); w.w = cvt_pk_bf16(v1[2], v1[3]);
                    *(u32x4*)(rowp + (size_t)bj * e.choff) = w;
                    if (e.dup) *(u32x4*)(rowp + (size_t)bj * e.choff + e.dup) = w;
                }
            }
    } else if (kind_ok(ph, EK_RES)) {
        const int col0 = wc * 32 + 4 * fq;
#pragma unroll
        for (int bj = 0; bj < 2; ++bj)
#pragma unroll
            for (int n = 0; n < 2; ++n) {
                f32x4 bs[2][4];
                const f32x4 mv = *(const f32x4*)(e.vec + col0 + bj * HALF + n * 16);
#pragma unroll
                for (int ai = 0; ai < 2; ++ai)
#pragma unroll
                    for (int m = 0; m < 4; ++m) bs[ai][m] = *(const f32x4*)(e.base + (size_t)(ai * HALF + wr * 64 + m * 16 + fr) * DM + col0 + bj * HALF + n * 16);
                asm volatile("" ::: "memory");
#pragma unroll
                for (int ai = 0; ai < 2; ++ai)
#pragma unroll
                    for (int m = 0; m < 4; ++m) {
                        const size_t off = (size_t)(ai * HALF + wr * 64 + m * 16 + fr) * DM + col0 + bj * HALF + n * 16;
                        float* dst = e.outf;
                        if (PH_REP[ph] > 1 && F.rep + 1 < PH_REP[ph]) dst = (float*)(F.ws + WS_U) + (e.outf - F.out);
                        *(f32x4*)(dst + off) = bs[ai][m] + mv * acc[ai][bj][m][n];
                    }
                asm volatile("" ::: "memory");
            }
    } else if (kind_ok(ph, EK_GATE) && e.kind == EK_GATE) {
        const unsigned col0 = wc * 32 + 8 * fq;
#pragma unroll
        for (int ai = 0; ai < 2; ++ai) {
            u32x4 uu[4][2]; float bsv[4];
#pragma unroll
            for (int m = 0; m < 4; ++m) {
                const int r = wr * 64 + m * 16 + fr;
                bsv[m] = e.bias[r];
                const bf16_t* up = e.U1p + (size_t)(ai * HALF + r) * 1024 + col0;
                uu[m][0] = *(const u32x4*)up; uu[m][1] = *(const u32x4*)(up + HALF);
            }
            asm volatile("" ::: "memory");
#pragma unroll
            for (int m = 0; m < 4; ++m) {
                const int r = wr * 64 + m * 16 + fr;
                bf16_t* rowp = e.O + (size_t)ai * e.hoff + (size_t)r * e.ldc + col0;
#pragma unroll
                for (int bj = 0; bj < 2; ++bj) {
                    const u32x4 u4 = uu[m][bj];
                    const f32x4 v0 = acc[ai][bj][m][0] + bsv[m], v1 = acc[ai][bj][m][1] + bsv[m];
                    u32x4 w;
                    w.x = cvt_pk_bf16(bflo(u4.x) * v0[0], bfhi(u4.x) * v0[1]); w.y = cvt_pk_bf16(bflo(u4.y) * v0[2], bfhi(u4.y) * v0[3]);
                    w.z = cvt_pk_bf16(bflo(u4.z) * v1[0], bfhi(u4.z) * v1[1]); w.w = cvt_pk_bf16(bflo(u4.w) * v1[2], bfhi(u4.w) * v1[3]);
                    *(u32x4*)(rowp + bj * HALF) = w;
                }
            }
            asm volatile("" ::: "memory");
        }
    } else if (kind_ok(ph, EK_Z2) && e.kind == EK_Z2) {
        const unsigned col0 = wc * 32 + 8 * fq;
#pragma unroll
        for (int ai = 0; ai < 2; ++ai)
#pragma unroll
            for (int m = 0; m < 4; ++m) {
                bf16_t* rowp = e.O + (size_t)((m * 16 + fr) * 128 + 2 * ai + wr) * e.ldc + col0;
#pragma unroll
                for (int bj = 0; bj < 2; ++bj) {
                    const f32x4 v0 = acc[ai][bj][m][0], v1 = acc[ai][bj][m][1];
                    u32x4 w; w.x = cvt_pk_bf16(v0[0], v0[1]); w.y = cvt_pk_bf16(v0[2], v0[3]); w.z = cvt_pk_bf16(v1[0], v1[1]); w.w = cvt_pk_bf16(v1[2], v1[3]);
                    *(u32x4*)(rowp + bj * HALF) = w;
                }
            }
    } else if (kind_ok(ph, EK_TW)) {
        const int a0 = 32 * (wc & 1) + 8 * fq;
        const float* twc = e.bias; const float* tws = e.bias + 8192;
#pragma unroll
        for (int m = 0; m < 4; ++m) {
            const int d = wr * 64 + m * 16 + fr;
            const f32x4 c0 = *(const f32x4*)(twc + d * 64 + a0), c1 = *(const f32x4*)(twc + d * 64 + a0 + 4);
            const f32x4 s0 = *(const f32x4*)(tws + d * 64 + a0), s1 = *(const f32x4*)(tws + d * 64 + a0 + 4);
#pragma unroll
            for (int bj = 0; bj < 2; ++bj) {
                const f32x4 r0 = acc[0][bj][m][0], r1 = acc[0][bj][m][1], i0 = acc[1][bj][m][0], i1 = acc[1][bj][m][1];
                const f32x4 yr0 = r0 * c0 + i0 * s0, yr1 = r1 * c1 + i1 * s1, yi0 = i0 * c0 - r0 * s0, yi1 = i1 * c1 - r1 * s1;
                bf16_t* p = e.O + (size_t)(2 * bj + (wc >> 1)) * 16384 + d * 128 + a0;
                u32x4 w; w.x = cvt_pk_bf16(yr0[0], yr0[1]); w.y = cvt_pk_bf16(yr0[2], yr0[3]); w.z = cvt_pk_bf16(yr1[0], yr1[1]); w.w = cvt_pk_bf16(yr1[2], yr1[3]);
                *(u32x4*)p = w;
                w.x = cvt_pk_bf16(yi0[0], yi0[1]); w.y = cvt_pk_bf16(yi0[2], yi0[3]); w.z = cvt_pk_bf16(yi1[0], yi1[1]); w.w = cvt_pk_bf16(yi1[2], yi1[3]);
                *(u32x4*)(p + 64) = w;
            }
        }
    }
}

__device__ __forceinline__ void filler_items(const Ctx& F, LAS unsigned char* lds, int ph, int first_idle);
__device__ __forceinline__ void gemm_phase(const Ctx& F, LAS unsigned char* lds, int ph) {
    const int tid = F.tid, wid = F.wave, lane = F.lane, wr = wid >> 2, wc = wid & 3, fr = lane & 15, fq = lane >> 4;
    const int nunits = gemm_units(ph);
    int Rr, Cc; stage_rc(tid * 16, Rr, Cc);
    const unsigned Ra = (unsigned)Rr, Rp = (unsigned)((Rr & ~31) + perm32(Rr & 31)), C2 = (unsigned)Cc * 2u;
    const unsigned ldsw = (unsigned)wid * 1024u;
    const int aoff = lds_byte(wr * 64 + fr, fq * 8), boff = lds_byte(wc * 32 + fr, fq * 8);
#define PG8_SA(b, h) (((b) * 2 + (h)) * HTB)
#define PG8_SB(b, h) ((4 + (b) * 2 + (h)) * HTB)
#define PG8_STAGE(bufoff, gbase, Rv, ld2) do { const unsigned _vo = (Rv) * (ld2) + C2; const char* _g = (gbase); \
        __builtin_amdgcn_global_load_lds((const unsigned*)(_g + _vo), (LAS unsigned*)(lds + (bufoff) + ldsw), 16, 0, 0); \
        __builtin_amdgcn_global_load_lds((const unsigned*)(_g + (size_t)64 * (ld2) + _vo), (LAS unsigned*)(lds + (bufoff) + ldsw + 8192), 16, 0, 0); } while (0)
#define PG8_LDA(dst, b, h) do { _Pragma("unroll") for (int m = 0; m < 4; ++m) _Pragma("unroll") for (int k = 0; k < 2; ++k) dst[m][k] = *(const LAS bf16x8*)(lds + PG8_SA(b, h) + aoff + m * 2048 + k * 1024); } while (0)
#define PG8_LDB(dst, b, h) do { _Pragma("unroll") for (int n = 0; n < 2; ++n) _Pragma("unroll") for (int k = 0; k < 2; ++k) dst[n][k] = *(const LAS bf16x8*)(lds + PG8_SB(b, h) + boff + n * 2048 + k * 1024); } while (0)
#define PG8_MMA(ai, bj, At, Bt) do { __builtin_amdgcn_s_setprio(1); _Pragma("unroll") for (int m = 0; m < 4; ++m) _Pragma("unroll") for (int n = 0; n < 2; ++n) _Pragma("unroll") for (int k = 0; k < 2; ++k) \
        acc[ai][bj][m][n] = __builtin_amdgcn_mfma_f32_16x16x32_bf16(Bt[n][k], At[m][k], acc[ai][bj][m][n], 0, 0, 0); __builtin_amdgcn_s_setprio(0); } while (0)
#define PG8_WAIT_V(n) asm volatile("s_waitcnt vmcnt(" #n ")" ::: "memory")
#define PG8_WAIT_L(n) asm volatile("s_waitcnt lgkmcnt(" #n ")" ::: "memory")
#define PG8_BAR __builtin_amdgcn_s_barrier()
#define PG8_SCHED __builtin_amdgcn_sched_barrier(0)
    int L = F.bid;
    if (L >= nunits) return;
    const unsigned* tab = (const unsigned*)(F.ws + WS_TAB) + (size_t)tab_off(ph) * 32;
    GU cur;
    load_gu(tab + (size_t)L * 32, cur);
    f32x4 acc[2][2][4][2];
#pragma unroll
    for (int a = 0; a < 2; ++a)
#pragma unroll
        for (int b = 0; b < 2; ++b)
#pragma unroll
            for (int m = 0; m < 4; ++m)
#pragma unroll
                for (int n = 0; n < 2; ++n) acc[a][b][m][n] = (f32x4){0.f, 0.f, 0.f, 0.f};
    bf16x8 At[4][2], B0[2][2], B1[2][2];
    const size_t kstep = (size_t)(BK * 2);
    {
        const unsigned Rb = cur.perm ? Rp : Ra; const size_t hA = cur.hA, hB = cur.hB;
        PG8_STAGE(PG8_SB(0, 0), cur.B, Rb, cur.ldb2); PG8_STAGE(PG8_SB(0, 1), cur.B + hB, Rb, cur.ldb2); PG8_STAGE(PG8_SA(0, 0), cur.A, Ra, cur.lda2); PG8_STAGE(PG8_SA(0, 1), cur.A + hA, Ra, cur.lda2);
        if (wr == 1) PG8_BAR;
        PG8_WAIT_V(2); PG8_BAR;
        PG8_STAGE(PG8_SB(1, 0), cur.B + kstep, Rb, cur.ldb2); PG8_STAGE(PG8_SA(1, 0), cur.A + kstep, Ra, cur.lda2); PG8_STAGE(PG8_SB(1, 1), cur.B + hB + kstep, Rb, cur.ldb2);
        PG8_WAIT_V(6); PG8_BAR;
    }
    for (;;) {
        const int Ln = L + F.G; const bool has_next = Ln < nunits;
        const char* cA = cur.A; const char* cB = cur.B; const int nt = cur.nt;
        const size_t hAc = cur.hA;
        for (int t = 0; t < nt; t += 2) {
            const bool last = (t == nt - 2);
            const char* a1 = cA + (size_t)(t + 1) * kstep;
            const char* a2 = cA + (size_t)(t + 2) * kstep; const char* b2 = cB + (size_t)(t + 2) * kstep;
            unsigned la2 = cur.lda2, lb2 = cur.ldb2; int pm2 = cur.perm; size_t hA2 = cur.hA, hB2 = cur.hB;
            if (last) { GU n2 = cur; if (has_next) load_gu(tab + (size_t)Ln * 32, n2); a2 = n2.A; b2 = n2.B; la2 = n2.lda2; lb2 = n2.ldb2; pm2 = n2.perm; hA2 = n2.hA; hB2 = n2.hB; }
            const unsigned Rb2 = pm2 ? Rp : Ra;
            const char* a3 = a2 + kstep; const char* b3 = b2 + kstep;
            PG8_LDB(B0, 0, 0); PG8_LDB(B1, 0, 1); PG8_SCHED; PG8_LDA(At, 0, 0); PG8_STAGE(PG8_SA(1, 1), a1 + hAc, Ra, cur.lda2);
            PG8_WAIT_V(8); PG8_WAIT_L(0); PG8_BAR; PG8_MMA(0, 0, At, B0); PG8_MMA(0, 1, At, B1); PG8_BAR; PG8_SCHED;
            PG8_LDA(At, 0, 1); PG8_STAGE(PG8_SB(0, 0), b2, Rb2, lb2); PG8_STAGE(PG8_SB(0, 1), b2 + hB2, Rb2, lb2); PG8_STAGE(PG8_SA(0, 0), a2, Ra, la2);
            PG8_WAIT_V(8); PG8_WAIT_L(0); PG8_BAR; PG8_MMA(1, 0, At, B0); PG8_MMA(1, 1, At, B1); PG8_BAR; PG8_SCHED;
            PG8_LDB(B0, 1, 0); PG8_LDB(B1, 1, 1); PG8_SCHED; PG8_LDA(At, 1, 0); PG8_STAGE(PG8_SA(0, 1), a2 + hA2, Ra, la2);
            PG8_WAIT_V(8); PG8_WAIT_L(0); PG8_BAR; PG8_MMA(0, 0, At, B0); PG8_MMA(0, 1, At, B1); PG8_BAR; PG8_SCHED;
            PG8_LDA(At, 1, 1); PG8_STAGE(PG8_SB(1, 0), b3, Rb2, lb2); PG8_STAGE(PG8_SB(1, 1), b3 + hB2, Rb2, lb2); PG8_STAGE(PG8_SA(1, 0), a3, Ra, la2);
            PG8_WAIT_V(8); PG8_WAIT_L(0); PG8_BAR; PG8_MMA(1, 0, At, B0); PG8_MMA(1, 1, At, B1); PG8_BAR; PG8_SCHED;
        }
        if (wr == 0) PG8_BAR;
        { EP ce; load_ep(tab + (size_t)L * 32, ce); run_epilogue(F, ph, ce, acc, wr, wc, fr, fq); }
        if (!has_next) break;
#pragma unroll
        for (int a = 0; a < 2; ++a)
#pragma unroll
            for (int b = 0; b < 2; ++b)
#pragma unroll
                for (int m = 0; m < 4; ++m)
#pragma unroll
                    for (int n = 0; n < 2; ++n) acc[a][b][m][n] = (f32x4){0.f, 0.f, 0.f, 0.f};
        L = Ln; load_gu(tab + (size_t)L * 32, cur);
        if (wr == 1) PG8_BAR;
    }
    PG8_WAIT_V(0);
    PG8_BAR;
    if (ph == PH_G_IN0 && F.bid >= 130) filler_items(F, lds, ph, 130);
    if ((ph == PH_G_UP0 || ph == PH_G_IN1) && F.bid >= 128) filler_items(F, lds, ph, 128);
#undef PG8_SA
#undef PG8_SB
#undef PG8_STAGE
#undef PG8_LDA
#undef PG8_LDB
#undef PG8_MMA
#undef PG8_WAIT_V
#undef PG8_WAIT_L
#undef PG8_BAR
#undef PG8_SCHED
}

constexpr int TR_SCR = 64 * 65 * 4;
struct TJ { const float* W; int ldw; bf16_t* WT; int ldt; int k0, n0; };
__device__ __forceinline__ TJ tr_decode(const Ctx& F, int list, int it) {
    unsigned char* ws = F.ws; TJ j; int nblk;
    constexpr int IUP = 32 * 176, IDN = 88 * 32, IIN1 = 32 * 48, UP1A = 1792;
    if (list == 0) {
        constexpr int I0 = 32 * 40, I1 = 16 * 32;
        if (it < I0) { j.W = FIN(8); j.ldw = 2560; nblk = 40; j.WT = (bf16_t*)(ws + WS_W_IN0); j.ldt = 2048; }
        else if ((it -= I0) < I1) { j.W = FIN(14); j.ldw = 2048; nblk = 32; j.WT = (bf16_t*)(ws + WS_W_OUT0X); j.ldt = 2048; }
        else if ((it -= I1) < I1) { j.W = FIN(14) + (size_t)1024 * 2048; j.ldw = 2048; nblk = 32; j.WT = (bf16_t*)(ws + WS_W_OB0); j.ldt = 1024; }
        else if ((it -= I1) < I1) { j.W = FIN(20); j.ldw = 2048; nblk = 32; j.WT = (bf16_t*)(ws + WS_W_OUT1X); j.ldt = 2048; }
        else { it -= I1; j.W = FIN(20) + (size_t)1024 * 2048; j.ldw = 2048; nblk = 32; j.WT = (bf16_t*)(ws + WS_W_OB1); j.ldt = 1024; }
    } else if (list == 1) { j.W = FIN(21); j.ldw = FF2; nblk = 176; j.WT = (bf16_t*)(ws + WS_W_UP0); j.ldt = 2048; }
    else if (list == 2) {
        if (it < IDN) { j.W = FIN(24); j.ldw = 2048; nblk = 32; j.WT = (bf16_t*)(ws + WS_W_DN0); j.ldt = FF; }
        else if ((it -= IDN) < IIN1) { j.W = FIN(15); j.ldw = 3072; nblk = 48; j.WT = (bf16_t*)(ws + WS_W_IN1); j.ldt = 2048; }
        else { it -= IIN1; j.W = FIN(21) + (size_t)DM * FF2; j.ldw = FF2; nblk = 176; j.WT = (bf16_t*)(ws + WS_W_UP1); j.ldt = 2048; }
    } else {
        if (it < IUP - UP1A) { it += UP1A; j.W = FIN(21) + (size_t)DM * FF2; j.ldw = FF2; nblk = 176; j.WT = (bf16_t*)(ws + WS_W_UP1); j.ldt = 2048; }
        else { it -= IUP - UP1A; j.W = FIN(24) + (size_t)FF * DM; j.ldw = 2048; nblk = 32; j.WT = (bf16_t*)(ws + WS_W_DN1); j.ldt = FF; }
    }
    j.k0 = 64 * (it / nblk); j.n0 = 64 * (it % nblk);
    return j;
}
__device__ __forceinline__ int tr_count(int list) {
    constexpr int IUP = 32 * 176, IDN = 88 * 32, IIN1 = 32 * 48, UP1A = 1792;
    return list == 0 ? 32 * 40 + 4 * 16 * 32 : list == 1 ? IUP : list == 2 ? IDN + IIN1 + UP1A : (IUP - UP1A) + IDN;
}
__device__ __forceinline__ void tr_load(const TJ& j, f32x4 (&v)[16], int lane) {
    const int kl = lane >> 4, nl = (lane & 15) * 4;
#pragma unroll
    for (int i = 0; i < 16; ++i) v[i] = __builtin_nontemporal_load((const f32x4*)(j.W + (size_t)(j.k0 + i * 4 + kl) * j.ldw + j.n0 + nl));
}
__device__ __forceinline__ void tr_store(const TJ& j, const f32x4 (&v)[16], LAS float* scr, int lane) {
    const int kl = lane >> 4, nl = (lane & 15) * 4;
#pragma unroll
    for (int i = 0; i < 16; ++i) { LAS float* d = scr + (i * 4 + kl) * 65 + nl; d[0] = v[i][0]; d[1] = v[i][1]; d[2] = v[i][2]; d[3] = v[i][3]; }
    asm volatile("s_waitcnt lgkmcnt(0)" ::: "memory");
    const int c = lane & 7;
#pragma unroll
    for (int q = 0; q < 8; ++q) { const int n = (lane >> 3) + 8 * q; const LAS float* sp = scr + (8 * c) * 65 + n;
        u32x4 o; o.x = cvt_pk_bf16(sp[0 * 65], sp[1 * 65]); o.y = cvt_pk_bf16(sp[2 * 65], sp[3 * 65]); o.z = cvt_pk_bf16(sp[4 * 65], sp[5 * 65]); o.w = cvt_pk_bf16(sp[6 * 65], sp[7 * 65]);
        *(u32x4*)(j.WT + (size_t)(j.n0 + n) * j.ldt + j.k0 + 8 * c) = o; }
    asm volatile("s_waitcnt lgkmcnt(0)" ::: "memory");
}
__device__ __forceinline__ void tr_run(const Ctx& F, LAS unsigned char* lds, int list, int first, int stride) {
    LAS float* scr = (LAS float*)(lds + F.wave * TR_SCR);
    const int total = tr_count(list);
    int it = first; if (it >= total) return;
    TJ j = tr_decode(F, list, it); f32x4 v[16]; tr_load(j, v, F.lane);
    for (;;) {
        const int itn = it + stride; const bool more = itn < total;
        TJ jn = j; f32x4 vn[16];
        if (more) { jn = tr_decode(F, list, itn); tr_load(jn, vn, F.lane); }
        tr_store(j, v, scr, F.lane);
        if (!more) break;
        j = jn; it = itn;
#pragma unroll
        for (int i = 0; i < 16; ++i) v[i] = vn[i];
    }
}

__device__ __forceinline__ void filler_items(const Ctx& F, LAS unsigned char* lds, int ph, int first_idle) {
    tr_run(F, lds, ph == PH_G_IN0 ? 1 : (ph == PH_G_UP0 ? 2 : 3), (F.bid - first_idle) * 8 + F.wave, (F.G - first_idle) * 8);
    __syncthreads();
}

__device__ __forceinline__ void phase_prep(const Ctx& F, LAS unsigned char* lds) {
    unsigned char* ws = F.ws;
    const int gw = F.bid * 8 + F.wave, NGW = F.G * 8;
    tr_run(F, lds, 0, gw, NGW);
    {
        const int gt = F.bid * 512 + F.tid, NGT = F.G * 512;
        bf16_t* wfo = (bf16_t*)(ws + WS_W_FO);
        for (int i = gt; i < 1024 * 1024 / 4; i += NGT) { const f32x4 v = *(const f32x4*)(FIN(19) + (size_t)i * 4); u32x2 o; o.x = cvt_pk_bf16(v[0], v[1]); o.y = cvt_pk_bf16(v[2], v[3]); *(u32x2*)(wfo + (size_t)i * 4) = o; }
        bf16_t* wpl = (bf16_t*)(ws + WS_W_POOL);
        for (int i = gt; i < 4 * 65536 / 4; i += NGT) { const int e0 = i * 4, g = e0 >> 16, co = e0 & 255; const f32x4 v = *(const f32x4*)(FIN(12) + e0); const f32x4 s = *(const f32x4*)(FIN(13) + g * 256 + co);
            u32x2 o; o.x = cvt_pk_bf16(v[0] * s[0], v[1] * s[1]); o.y = cvt_pk_bf16(v[2] * s[2], v[3] * s[3]); *(u32x2*)(wpl + e0) = o; }
        bf16_t* wsp = (bf16_t*)(ws + WS_W_SPBD);
        for (int i = gt; i < 4 * 65536; i += NGT) { const int g = i >> 16, p = (i >> 8) & 255, q = i & 255;
            const float v = ((p >> 7) == (q >> 7)) ? FIN(17)[g * 16384 + (p & 127) * 128 + (q & 127)] : 0.f; wsp[i] = f2bf(v); }
        bf16_t* a1 = (bf16_t*)(ws + WS_W_A1);
        for (int i = gt; i < 256 * 256; i += NGT) { const int r = i >> 8, k = i & 255, pp = r >> 7, d = r & 127, p = k >> 7, b = k & 127; const float x = (float)((b * d) & 127) * (1.0f / 64.0f);
            const float v = (pp == p ? cospif(x) : (pp == 0 ? sinpif(x) : -sinpif(x))) * 0.08838834764831845f; a1[i] = f2bf(v); }
        bf16_t* a2 = (bf16_t*)(ws + WS_W_A2);
        for (int i = gt; i < 256 * 512; i += NGT) { const int r = i >> 9, k = i & 511, dj = r >> 6, c = r & 63, dk = k >> 7, pp = (k >> 6) & 1, a = k & 63; const float x = (float)((a * c) & 63) * (1.0f / 32.0f);
            const float v = dj == dk ? (pp ? sinpif(x) : cospif(x)) * 0.125f : 0.f; a2[i] = f2bf(v); }
        float* tw = (float*)(ws + WS_TW);
        for (int i = gt; i < 8192; i += NGT) { const int d = i >> 6, a = i & 63; const float x = (float)(a * d) * (1.0f / 4096.0f); tw[i] = cospif(x); tw[8192 + i] = sinpif(x); }
        bf16_t* chd = (bf16_t*)(ws + WS_W_CHD);
        for (int i = gt; i < 256 * 128; i += NGT) { const int n = i >> 7, j = i & 127, part = n >> 7, m = n & 127; const float x = (float)((m * j) & 127) * (1.0f / 64.0f);
            const float v = (part == 0 ? cospif(x) : -sinpif(x)) * 0.08838834764831845f; chd[i] = f2bf(v); }
    }
    {
        const int gt = F.bid * 512 + F.tid, NGT = F.G * 512;
        for (int i = gt; i < TAB_UNITS; i += NGT) {
            int ph = PH_G_DN1;
            if (i < 386) ph = PH_G_IN0; else if (i < 642) ph = PH_G_OUT0; else if (i < 2050) ph = PH_G_UP0; else if (i < 2306) ph = PH_G_DN0; else if (i < 2690) ph = PH_G_IN1;
            else if (i < 2946) ph = PH_G_F1; else if (i < 3202) ph = PH_G_S1; else if (i < 3458) ph = PH_G_S2; else if (i < 3714) ph = PH_G_OUT1; else if (i < 5122) ph = PH_G_UP1;
            GU u; EP e; unit_desc(F, ph, i - tab_off(ph), u, e);
            store_rec((unsigned long long*)(ws + WS_TAB) + (size_t)i * 16, u, e);
        }
    }
}

__device__ __forceinline__ void phase_gemv(const Ctx& F, LAS unsigned char* lds) {
    float* mod = (float*)(F.ws + WS_CTL); float* modc = mod + 2 * 12288;
    LAS f32x2* red = (LAS f32x2*)lds;
    LAS float* sl = (LAS float*)(lds + 16384);
    if (F.bid < 192) {
        for (int i = F.tid; i < 4096; i += 512) { const float v = i < 2048 ? FIN(1)[i] : FIN(3)[i - 2048]; sl[i] = v / (1.f + __expf(-v)); }
        __syncthreads();
    }
    for (int it = F.bid; it < 192; it += F.G) {
        const int l = it / 96, cb = it % 96; const bool dc = (l == 0) && (cb * 128 < 4096);
        const int n0 = cb * 128 + F.lane * 2, k0 = F.wave * 256;
        const float* wp = FIN(4) + ((size_t)l * DM + k0) * 12288 + n0;
        f32x2 a = {0.f, 0.f}, ac = {0.f, 0.f};
        for (int kb = 0; kb < 256; kb += 32) {
            f32x2 w[32];
#pragma unroll
            for (int k = 0; k < 32; ++k) w[k] = __builtin_nontemporal_load((const f32x2*)(wp + (size_t)(kb + k) * 12288));
#pragma unroll
            for (int k = 0; k < 32; ++k) { a += w[k] * sl[k0 + kb + k]; if (dc) ac += w[k] * sl[2048 + k0 + kb + k]; }
        }
        __syncthreads();
        red[(F.wave * 64 + F.lane) * 2] = a; red[(F.wave * 64 + F.lane) * 2 + 1] = ac;
        __syncthreads();
        if (F.tid < 64) {
            f32x2 sa = *(const f32x2*)(FIN(5) + l * 12288 + n0), sc = sa;
#pragma unroll
            for (int w8 = 0; w8 < 8; ++w8) { sa += red[(w8 * 64 + F.lane) * 2]; sc += red[(w8 * 64 + F.lane) * 2 + 1]; }
            *(f32x2*)(mod + l * 12288 + n0) = sa;
            if (dc) *(f32x2*)(modc + n0) = sc;
        }
    }
    __syncthreads();
}

__device__ __forceinline__ void norm_rows(const Ctx& F, const float* X, const float* Xc, int nrows, const float* g, const float* shift, const float* scale, const float* shiftc, const float* scalec, bf16_t* Hout) {
    const int gw = F.bid * 8 + F.wave, NGW = F.G * 8;
    for (int row0 = gw; row0 < nrows; row0 += 2 * NGW) {
        f32x4 v[2][8]; float ss[2];
#pragma unroll
        for (int h = 0; h < 2; ++h) {
            const int row = row0 + h * NGW;
            if (row < nrows) {
                const bool isc = row >= NT;
                const f32x4* xr = (const f32x4*)(isc ? Xc + (size_t)(row - NT) * DM : X + (size_t)row * DM) + F.lane;
#pragma unroll
                for (int j = 0; j < 8; ++j) v[h][j] = xr[64 * j];
            } else {
#pragma unroll
                for (int j = 0; j < 8; ++j) v[h][j] = (f32x4){0.f, 0.f, 0.f, 0.f};
            }
        }
#pragma unroll
        for (int h = 0; h < 2; ++h) { float s = 0.f;
#pragma unroll
            for (int j = 0; j < 8; ++j) s += (v[h][j][0] * v[h][j][0] + v[h][j][1] * v[h][j][1]) + (v[h][j][2] * v[h][j][2] + v[h][j][3] * v[h][j][3]);
            ss[h] = wave_sum(s); }
#pragma unroll
        for (int h = 0; h < 2; ++h) {
            const int row = row0 + h * NGW;
            if (row < nrows) {
                const bool isc = row >= NT;
                const float* shp = isc ? shiftc : shift; const float* scp = isc ? scalec : scale;
                const float rstd = 1.0f / sqrtf(ss[h] * (1.0f / DM) + EPS);
#pragma unroll
                for (int j = 0; j < 8; ++j) {
                    const int col = 4 * F.lane + 256 * j;
                    const f32x4 g4 = *(const f32x4*)(g + col), sh = *(const f32x4*)(shp + col), sc = *(const f32x4*)(scp + col);
                    const f32x4 o = (v[h][j] * rstd) * g4 * (sc + 1.0f) + sh;
                    u32x2 w; w.x = cvt_pk_bf16(o[0], o[1]); w.y = cvt_pk_bf16(o[2], o[3]);
                    *(u32x2*)(Hout + (size_t)row * DM + col) = w;
                }
            }
        }
    }
}

template <int HW> __device__ __forceinline__ void pool_item(const bf16_t* ZB, bf16_t* CAT, int t0, int c0) {
    constexpr int NR = 8 + 2 * HW;
    u32x4 rows[NR];
#pragma unroll
    for (int r = 0; r < NR; ++r) { const int tok = t0 - HW + r; rows[r] = (tok >= 0 && tok < NT) ? *(const u32x4*)(ZB + (size_t)tok * 1024 + c0) : (u32x4){0u, 0u, 0u, 0u}; }
    float s[8] = {0.f, 0.f, 0.f, 0.f, 0.f, 0.f, 0.f, 0.f};
#pragma unroll
    for (int r = 0; r < 2 * HW; ++r) { const u32x4 z = rows[r];
        s[0] += bflo(z.x); s[1] += bfhi(z.x); s[2] += bflo(z.y); s[3] += bfhi(z.y); s[4] += bflo(z.z); s[5] += bfhi(z.z); s[6] += bflo(z.w); s[7] += bfhi(z.w); }
#pragma unroll
    for (int j = 0; j < 8; ++j) {
        const int t = t0 + j; const int lo = t - HW < 0 ? 0 : t - HW, hi = t + HW > NT ? NT : t + HW;
        const float rc = 1.0f / (float)(hi - lo);
        const u32x4 z = rows[HW + j];
        u32x4 o; o.x = cvt_pk_bf16(s[0] * rc - bflo(z.x), s[1] * rc - bfhi(z.x)); o.y = cvt_pk_bf16(s[2] * rc - bflo(z.y), s[3] * rc - bfhi(z.y));
        o.z = cvt_pk_bf16(s[4] * rc - bflo(z.z), s[5] * rc - bfhi(z.z)); o.w = cvt_pk_bf16(s[6] * rc - bflo(z.w), s[7] * rc - bfhi(z.w));
        *(u32x4*)(CAT + (size_t)t * 2048 + 1024 + c0) = o;
        if (j < 7) { const u32x4 zo = rows[j], zn = rows[j + 2 * HW];
            s[0] += bflo(zn.x) - bflo(zo.x); s[1] += bfhi(zn.x) - bfhi(zo.x); s[2] += bflo(zn.y) - bflo(zo.y); s[3] += bfhi(zn.y) - bfhi(zo.y);
            s[4] += bflo(zn.z) - bflo(zo.z); s[5] += bfhi(zn.z) - bfhi(zo.z); s[6] += bflo(zn.w) - bflo(zo.w); s[7] += bfhi(zn.w) - bfhi(zo.w); }
    }
}
__device__ __forceinline__ float row16_sum(float v) {
    v += __shfl_xor(v, 1); v += __shfl_xor(v, 2); v += __shfl_xor(v, 4); v += __shfl_xor(v, 8); return v;
}
__device__ __forceinline__ void phase_qkpool(const Ctx& F) {
    unsigned char* ws = F.ws;
    const int gw = F.bid * 8 + F.wave, NGW = F.G * 8;
    bf16_t* QB = (bf16_t*)(ws + WS_QB); bf16_t* KB = (bf16_t*)(ws + WS_KB);
    const int hs = F.lane >> 4, li = F.lane & 15, half = li >> 3, i0 = 4 * (li & 7), e1 = half * 64 + i0;
    float inv[4], gq1[4], gq2[4], gk1[4], gk2[4];
#pragma unroll
    for (int j = 0; j < 4; ++j) { inv[j] = exp2f(-(float)(i0 + j) * (13.287712379549449f / 32.0f)); gq1[j] = FIN(9)[e1 + j]; gq2[j] = FIN(9)[e1 + 32 + j]; gk1[j] = FIN(10)[e1 + j]; gk2[j] = FIN(10)[e1 + 32 + j]; }
    for (int row = gw; row < MR; row += NGW) {
        const bool isctx = row >= NT;
        float cs[4], sn[4];
        const float pos = isctx ? 0.f : (float)(half == 0 ? (row >> 6) : (row & 63));
#pragma unroll
        for (int j = 0; j < 4; ++j) { const float a = pos * inv[j]; sn[j] = __sinf(a); cs[j] = __cosf(a); }
        bf16_t* ptr[3]; bool act[3]; u32x2 v1[3], v2[3];
#pragma unroll
        for (int ps = 0; ps < 3; ++ps) { const int h = ps * 4 + hs; act[ps] = h < 8 ? !isctx : (h < 10);
            ptr[ps] = h < 8 ? QB + (size_t)(isctx ? 0 : row) * 1024 + h * 128 + e1 : KB + (size_t)row * 256 + ((h - 8) & 1) * 128 + e1;
            if (act[ps]) { v1[ps] = *(const u32x2*)ptr[ps]; v2[ps] = *(const u32x2*)(ptr[ps] + 32); } else { v1[ps] = (u32x2){0u, 0u}; v2[ps] = (u32x2){0u, 0u}; } }
#pragma unroll
        for (int ps = 0; ps < 3; ++ps) {
            const bool isq = (ps * 4 + hs) < 8;
            float x1[4] = {bflo(v1[ps].x), bfhi(v1[ps].x), bflo(v1[ps].y), bfhi(v1[ps].y)}, x2[4] = {bflo(v2[ps].x), bfhi(v2[ps].x), bflo(v2[ps].y), bfhi(v2[ps].y)};
            float ss = 0.f;
#pragma unroll
            for (int j = 0; j < 4; ++j) ss += x1[j] * x1[j] + x2[j] * x2[j];
            ss = row16_sum(ss);
            const float r = 1.0f / sqrtf(ss * (1.0f / 128.0f) + EPS);
            float o1[4], o2[4];
#pragma unroll
            for (int j = 0; j < 4; ++j) { const float y1 = x1[j] * r * (isq ? gq1[j] : gk1[j]), y2 = x2[j] * r * (isq ? gq2[j] : gk2[j]); o1[j] = y1 * cs[j] - y2 * sn[j]; o2[j] = y2 * cs[j] + y1 * sn[j]; }
            if (act[ps]) { u32x2 w1, w2; w1.x = cvt_pk_bf16(o1[0], o1[1]); w1.y = cvt_pk_bf16(o1[2], o1[3]); w2.x = cvt_pk_bf16(o2[0], o2[1]); w2.y = cvt_pk_bf16(o2[2], o2[3]);
                *(u32x2*)ptr[ps] = w1; *(u32x2*)(ptr[ps] + 32) = w2; }
        }
    }
    const bf16_t* ZB = (const bf16_t*)(ws + WS_ZB); bf16_t* CAT = (bf16_t*)(ws + WS_CAT);
    const int gt = F.bid * 512 + F.tid, NGT = F.G * 512;
    for (int id = gt; id < (NT / 8) * 128; id += NGT) {
        const int t0 = (id >> 7) * 8, c0 = (id & 127) * 8, g = c0 >> 8;
        if (g == 0) pool_item<1>(ZB, CAT, t0, c0); else if (g == 1) pool_item<2>(ZB, CAT, t0, c0); else if (g == 2) pool_item<4>(ZB, CAT, t0, c0); else pool_item<8>(ZB, CAT, t0, c0);
    }
}

__device__ __forceinline__ void phase_attn(const Ctx& F, LAS unsigned char* lds) {
    unsigned char* ws = F.ws;
    const bf16_t* QB = (const bf16_t*)(ws + WS_QB); const bf16_t* KB = (const bf16_t*)(ws + WS_KB); const bf16_t* VT = (const bf16_t*)(ws + WS_VT);
    bf16_t* CAT = (bf16_t*)(ws + WS_CAT);
    LAS bf16_t* Ks = (LAS bf16_t*)lds;
    LAS bf16_t* Vs = (LAS bf16_t*)(lds + 64 * 272);
    const int lane = F.lane, w = F.wave, fr = lane & 15, fq = lane >> 4, tid = F.tid;
    const float cexp = 0.08838834764831845f * 1.4426950408889634f;
    for (int L = F.bid; L < 512; L += F.G) {
        const int qb = L >> 3, hq = L & 7, hk = hq >> 2;
        const int qrow = qb * 128 + w * 16 + fr;
        bf16x8 qf[4];
#pragma unroll
        for (int ks = 0; ks < 4; ++ks) qf[ks] = *(const bf16x8*)(QB + (size_t)qrow * 1024 + hq * 128 + ks * 32 + fq * 8);
        f32x4 o[8];
#pragma unroll
        for (int d = 0; d < 8; ++d) o[d] = (f32x4){0.f, 0.f, 0.f, 0.f};
        float mrun = -1e30f, lrun = 0.f;
        u32x4 kreg[2], vreg[2];
        int ti = 0;
#define ATT_TILE(ti_, ks_, mk_) do { if ((ti_) < 2) { ks_ = qb * 128 + (ti_) * 64; mk_ = 0; } else if ((ti_) < 4) { ks_ = (qb - 1) * 128 + ((ti_) - 2) * 64; mk_ = 1; } \
            else if ((ti_) < 6) { ks_ = (qb + 1) * 128 + ((ti_) - 4) * 64; mk_ = 2; } else { ks_ = NT + ((ti_) - 6) * 64; mk_ = 0; } } while (0)
#define ATT_SKIP(ti_) (((ti_) >= 2 && (ti_) < 4 && qb == 0) || ((ti_) >= 4 && (ti_) < 6 && qb == 63))
#define ATT_LOAD(ks_) do { _Pragma("unroll") for (int it = 0; it < 2; ++it) { const int id = tid + 512 * it; \
                kreg[it] = *(const u32x4*)(KB + (size_t)((ks_) + (id >> 4)) * 256 + hk * 128 + (id & 15) * 8); \
                vreg[it] = *(const u32x4*)(VT + (size_t)(hk * 128 + (id >> 3)) * MR + (ks_) + (id & 7) * 8); } } while (0)
        { int ks0, mk0; ATT_TILE(0, ks0, mk0); (void)mk0; ATT_LOAD(ks0); }
        for (; ti < 10; ) {
            int kstart, mk; ATT_TILE(ti, kstart, mk);
            int tn = ti + 1; while (tn < 10 && ATT_SKIP(tn)) ++tn;
            __syncthreads();
#pragma unroll
            for (int it = 0; it < 2; ++it) { const int id = tid + 512 * it;
                *(LAS u32x4*)(Ks + (id >> 4) * 136 + (id & 15) * 8) = kreg[it];
                *(LAS u32x4*)(Vs + (id >> 3) * 72 + (id & 7) * 8) = vreg[it]; }
            if (tn < 10) { int ksn, mkn; ATT_TILE(tn, ksn, mkn); (void)mkn; ATT_LOAD(ksn); }
            ti = tn;
            __syncthreads();
            f32x4 s[4];
#pragma unroll
            for (int sub = 0; sub < 4; ++sub) {
                s[sub] = (f32x4){0.f, 0.f, 0.f, 0.f};
#pragma unroll
                for (int ks = 0; ks < 4; ++ks) {
                    const bf16x8 kf = *(const LAS bf16x8*)(Ks + (sub * 16 + fr) * 136 + ks * 32 + fq * 8);
                    s[sub] = __builtin_amdgcn_mfma_f32_16x16x32_bf16(kf, qf[ks], s[sub], 0, 0, 0);
                }
            }
            if (mk) {
#pragma unroll
                for (int sub = 0; sub < 4; ++sub)
#pragma unroll
                    for (int j = 0; j < 4; ++j) { const int kpos = kstart + sub * 16 + fq * 4 + j; const int df = mk == 1 ? qrow - kpos : kpos - qrow; if (df > 128) s[sub][j] = -1e30f; }
            }
            float tm = -1e30f;
#pragma unroll
            for (int sub = 0; sub < 4; ++sub)
#pragma unroll
                for (int j = 0; j < 4; ++j) tm = fmaxf(tm, s[sub][j]);
            tm = fmaxf(tm, __shfl_xor(tm, 16)); tm = fmaxf(tm, __shfl_xor(tm, 32));
            const float mnew = fmaxf(mrun, tm);
            const float alpha = exp2f((mrun - mnew) * cexp);
            mrun = mnew;
            float ps = 0.f;
#pragma unroll
            for (int sub = 0; sub < 4; ++sub)
#pragma unroll
                for (int j = 0; j < 4; ++j) { const float p = exp2f((s[sub][j] - mnew) * cexp); s[sub][j] = p; ps += p; }
            lrun = lrun * alpha + ps;
#pragma unroll
            for (int d = 0; d < 8; ++d) o[d] = o[d] * alpha;
#pragma unroll
            for (int kk = 0; kk < 2; ++kk) {
                u32x4 pw; pw.x = cvt_pk_bf16(s[2 * kk][0], s[2 * kk][1]); pw.y = cvt_pk_bf16(s[2 * kk][2], s[2 * kk][3]);
                pw.z = cvt_pk_bf16(s[2 * kk + 1][0], s[2 * kk + 1][1]); pw.w = cvt_pk_bf16(s[2 * kk + 1][2], s[2 * kk + 1][3]);
                const bf16x8 pf = __builtin_bit_cast(bf16x8, pw);
#pragma unroll
                for (int d = 0; d < 8; ++d) {
                    const LAS bf16_t* vp = Vs + (d * 16 + fr) * 72 + kk * 32 + fq * 4;
                    const u32x2 lo = *(const LAS u32x2*)vp, hi = *(const LAS u32x2*)(vp + 16);
                    u32x4 vw; vw.x = lo.x; vw.y = lo.y; vw.z = hi.x; vw.w = hi.y;
                    o[d] = __builtin_amdgcn_mfma_f32_16x16x32_bf16(__builtin_bit_cast(bf16x8, vw), pf, o[d], 0, 0, 0);
                }
            }
        }
#undef ATT_TILE
#undef ATT_SKIP
#undef ATT_LOAD
        lrun += __shfl_xor(lrun, 16); lrun += __shfl_xor(lrun, 32);
        lrun += exp2f(FIN(11)[hq] * 1.4426950408889634f - mrun * cexp);
        const float rl = 1.0f / lrun;
#pragma unroll
        for (int d = 0; d < 8; ++d) {
            u32x2 wv; wv.x = cvt_pk_bf16(o[d][0] * rl, o[d][1] * rl); wv.y = cvt_pk_bf16(o[d][2] * rl, o[d][3] * rl);
            *(u32x2*)(CAT + (size_t)qrow * 2048 + hq * 128 + d * 16 + fq * 4) = wv;
        }
    }
    __syncthreads();
}

__device__ __forceinline__ void phase_conv(const Ctx& F, int layer) {
    unsigned char* ws = F.ws;
    const bf16_t* U = (const bf16_t*)(ws + WS_U); bf16_t* ACT = (bf16_t*)(ws + WS_ACT);
    const float* cw = FIN(22) + (size_t)layer * 3 * FF2; const float* cb = FIN(23) + (size_t)layer * FF2;
    const int gw = F.bid * 8 + F.wave, NGW = F.G * 8;
    for (int it = gw; it < 256 * 11; it += NGW) {
        const int tc = it / 11, cbk = it % 11; const int c0 = cbk * 512 + F.lane * 8, t0 = tc * 32;
        float wg[3][8], wv[3][8], bg[8], bv[8];
#pragma unroll
        for (int r = 0; r < 3; ++r)
#pragma unroll
            for (int j = 0; j < 8; j += 4) { const f32x4 a = *(const f32x4*)(cw + (size_t)r * FF2 + c0 + j), b = *(const f32x4*)(cw + (size_t)r * FF2 + FF + c0 + j);
                wg[r][j] = a[0]; wg[r][j + 1] = a[1]; wg[r][j + 2] = a[2]; wg[r][j + 3] = a[3]; wv[r][j] = b[0]; wv[r][j + 1] = b[1]; wv[r][j + 2] = b[2]; wv[r][j + 3] = b[3]; }
#pragma unroll
        for (int j = 0; j < 8; j += 4) { const f32x4 a = *(const f32x4*)(cb + c0 + j), b = *(const f32x4*)(cb + FF + c0 + j);
            bg[j] = a[0]; bg[j + 1] = a[1]; bg[j + 2] = a[2]; bg[j + 3] = a[3]; bv[j] = b[0]; bv[j + 1] = b[1]; bv[j + 2] = b[2]; bv[j + 3] = b[3]; }
        const u32x4 zero = {0u, 0u, 0u, 0u};
        u32x4 pg, pv, cg_, cv;
        if (t0 > 0) { pg = *(const u32x4*)(U + (size_t)(t0 - 1) * FF2 + c0); pv = *(const u32x4*)(U + (size_t)(t0 - 1) * FF2 + FF + c0); } else { pg = zero; pv = zero; }
        cg_ = *(const u32x4*)(U + (size_t)t0 * FF2 + c0); cv = *(const u32x4*)(U + (size_t)t0 * FF2 + FF + c0);
        for (int tb = t0; tb < t0 + 32; tb += 8) {
            u32x4 rg[8], rv[8];
#pragma unroll
            for (int q = 0; q < 8; ++q) { const int tt = tb + 1 + q;
                if (tt < NT) { rg[q] = *(const u32x4*)(U + (size_t)tt * FF2 + c0); rv[q] = *(const u32x4*)(U + (size_t)tt * FF2 + FF + c0); } else { rg[q] = zero; rv[q] = zero; } }
#pragma unroll
            for (int q8 = 0; q8 < 8; ++q8) {
                const int t = tb + q8; const u32x4 ng = rg[q8], nv = rv[q8];
                float og[8], ov[8];
#pragma unroll
                for (int q = 0; q < 4; ++q) {
                    og[2 * q] = wg[0][2 * q] * bflo(pg[q]) + wg[1][2 * q] * bflo(cg_[q]) + wg[2][2 * q] * bflo(ng[q]) + bg[2 * q];
                    og[2 * q + 1] = wg[0][2 * q + 1] * bfhi(pg[q]) + wg[1][2 * q + 1] * bfhi(cg_[q]) + wg[2][2 * q + 1] * bfhi(ng[q]) + bg[2 * q + 1];
                    ov[2 * q] = wv[0][2 * q] * bflo(pv[q]) + wv[1][2 * q] * bflo(cv[q]) + wv[2][2 * q] * bflo(nv[q]) + bv[2 * q];
                    ov[2 * q + 1] = wv[0][2 * q + 1] * bfhi(pv[q]) + wv[1][2 * q + 1] * bfhi(cv[q]) + wv[2][2 * q + 1] * bfhi(nv[q]) + bv[2 * q + 1];
                }
                float r[8];
#pragma unroll
                for (int j = 0; j < 8; ++j) r[j] = og[j] / (1.f + __expf(-og[j])) * ov[j];
                u32x4 o; o.x = cvt_pk_bf16(r[0], r[1]); o.y = cvt_pk_bf16(r[2], r[3]); o.z = cvt_pk_bf16(r[4], r[5]); o.w = cvt_pk_bf16(r[6], r[7]);
                *(u32x4*)(ACT + (size_t)t * FF + c0) = o;
                pg = cg_; pv = cv; cg_ = ng; cv = nv;
            }
        }
    }
}

__device__ __forceinline__ void phase_vtn(const Ctx& F, LAS unsigned char* lds) {
    unsigned char* ws = F.ws;
    const bf16_t* GV = (const bf16_t*)(ws + WS_GV); bf16_t* VTN = (bf16_t*)(ws + WS_VTN);
    LAS bf16_t* tile = (LAS bf16_t*)lds;
    LAS float* rs = (LAS float*)(lds + 32 * 1032 * 2);
    const float* gn = FIN(16);
    for (int it = F.bid; it < 256; it += F.G) {
        const int t0 = it * 32;
        __syncthreads();
#pragma unroll
        for (int i = 0; i < 8; ++i) { const int id = F.tid + 512 * i, r = id >> 7, c = (id & 127) * 8; *(LAS u32x4*)(tile + r * 1032 + c) = *(const u32x4*)(GV + (size_t)(t0 + r) * 1024 + c); }
        __syncthreads();
#pragma unroll
        for (int i = 0; i < 4; ++i) { const int r = F.wave * 4 + i; float s = 0.f;
#pragma unroll
            for (int j = 0; j < 2; ++j) { const u32x4 z = *(const LAS u32x4*)(tile + r * 1032 + (F.lane + 64 * j) * 8);
                s += bflo(z.x) * bflo(z.x) + bfhi(z.x) * bfhi(z.x) + bflo(z.y) * bflo(z.y) + bfhi(z.y) * bfhi(z.y) + bflo(z.z) * bflo(z.z) + bfhi(z.z) * bfhi(z.z) + bflo(z.w) * bflo(z.w) + bfhi(z.w) * bfhi(z.w); }
            s = wave_sum(s); if (F.lane == 0) rs[r] = 1.0f / sqrtf(s * (1.0f / 1024.0f) + EPS); }
        __syncthreads();
#pragma unroll
        for (int i = 0; i < 8; ++i) { const int id = F.tid + 512 * i, c = id >> 2, tq = id & 3; const float gc = gn[c];
            float v[8];
#pragma unroll
            for (int j = 0; j < 8; ++j) v[j] = bf2f(tile[(tq * 8 + j) * 1032 + c]) * rs[tq * 8 + j] * gc;
            u32x4 o; o.x = cvt_pk_bf16(v[0], v[1]); o.y = cvt_pk_bf16(v[2], v[3]); o.z = cvt_pk_bf16(v[4], v[5]); o.w = cvt_pk_bf16(v[6], v[7]);
            *(u32x4*)(VTN + (size_t)c * 8192 + t0 + tq * 8) = o; }
    }
    __syncthreads();
}


#define XB_TMO      128
#define XB_XCNT(j)  (256  + 64 * (j))
#define XB_XSUB(j)  (1280 + 64 * (j))
#define XB_XGEN(j)  (2304 + 64 * (j))
#define XB_TOP      3328
#define XB_TOPGEN   3392
#define XCD_BAR_WORDS 3456
#define XB_SPIN_CAP (1u << 18)
__device__ __forceinline__ unsigned xb_ld(unsigned* p)              { return __hip_atomic_load(p, __ATOMIC_RELAXED, __HIP_MEMORY_SCOPE_AGENT); }
__device__ __forceinline__ unsigned xb_add(unsigned* p, unsigned v) { return __hip_atomic_fetch_add(p, v, __ATOMIC_RELAXED, __HIP_MEMORY_SCOPE_AGENT); }
__device__ __forceinline__ unsigned xb_xcc_id() { return (unsigned)__builtin_amdgcn_s_getreg((3 << 11) | 20) & 0xFu; }
#define XB_SPIN(cond, bar) do { unsigned _sp = 0; while (cond) { __builtin_amdgcn_s_sleep(1); \
    if ((++_sp & 255u) == 0u) { if (xb_ld(&(bar)[XB_TMO])) break; if (_sp > XB_SPIN_CAP) { atomicAdd(&(bar)[XB_TMO], 1u); break; } } } } while (0)
struct XcdBarrier { unsigned* bar; unsigned x; volatile LAS unsigned* st; };
__device__ __forceinline__ XcdBarrier xcd_barrier_post(unsigned* bar, volatile LAS unsigned* st) {
    XcdBarrier b; b.bar = bar; b.x = xb_xcc_id(); b.st = st;
    if (threadIdx.x == 0) (void)xb_add(&bar[XB_XCNT(b.x)], 1u);
    return b;
}
__device__ __forceinline__ void xcd_barrier_complete(unsigned* bar, unsigned x, unsigned& nloc, unsigned& nx) {
    const unsigned G = gridDim.x * gridDim.y * gridDim.z;
    unsigned sum, cnt, mine, sp = 0u;
    for (;;) {
        sum = 0u; cnt = 0u; mine = 0u;
#pragma unroll
        for (unsigned j = 0; j < 16; ++j) { const unsigned c = xb_ld(&bar[XB_XCNT(j)]); sum += c; cnt += (c > 0u) ? 1u : 0u; mine = (j == x) ? c : mine; }
        if (sum == G) break;
        __builtin_amdgcn_s_sleep(1);
        if ((++sp & 255u) == 0u) { if (xb_ld(&bar[XB_TMO])) break; if (sp > XB_SPIN_CAP) { atomicAdd(&bar[XB_TMO], 1u); break; } }
    }
    nloc = mine > 0u ? mine : 1u; nx = cnt > 0u ? cnt : 1u;
}
__device__ __forceinline__ void xcd_barrier(const XcdBarrier& b) {
    asm volatile("s_waitcnt vmcnt(0)" ::: "memory");
    __syncthreads();
    if (threadIdx.x == 0) {
        unsigned* bar = b.bar;
        __builtin_amdgcn_s_waitcnt(0);
        unsigned nloc = b.st[0], nx = b.st[1];
        if (nloc == 0u) { xcd_barrier_complete(bar, b.x, nloc, nx); b.st[0] = nloc; b.st[1] = nx; }
        const unsigned old = xb_add(&bar[XB_XSUB(b.x)], 1u);
        const unsigned gen = old / nloc;
        if (old + 1u == (gen + 1u) * nloc) {
            __builtin_amdgcn_fence(__ATOMIC_RELEASE, "agent");
            asm volatile("s_waitcnt vmcnt(0)" ::: "memory");
            const unsigned og = xb_add(&bar[XB_TOP], 1u);
            const unsigned tg = og / nx;
            if (og + 1u == (tg + 1u) * nx) xb_add(&bar[XB_TOPGEN], 1u);
            else XB_SPIN(xb_ld(&bar[XB_TOPGEN]) == tg, bar);
            __builtin_amdgcn_fence(__ATOMIC_ACQUIRE, "agent");
            xb_add(&bar[XB_XGEN(b.x)], 1u);
            asm volatile("s_waitcnt vmcnt(0)" ::: "memory");
        } else {
            XB_SPIN(xb_ld(&bar[XB_XGEN(b.x)]) == gen, bar);
            __builtin_amdgcn_fence(__ATOMIC_ACQUIRE, "agent");
            asm volatile("s_waitcnt vmcnt(0)" ::: "memory");
        }
    }
    __syncthreads();
}
constexpr size_t WS_BAR = 512 * 1024;

constexpr int MISC_OFF = 8 * TR_SCR + 1024, LDS_BYTES = MISC_OFF + 1024;
static_assert(MISC_OFF >= STAGE_BYTES && LDS_BYTES <= 160 * 1024, "LDS map");
__global__ void __launch_bounds__(512, 2) fwd_mega(Args args) {
    extern __shared__ __attribute__((aligned(16))) unsigned char lds_raw[];
    LAS unsigned char* lds = (LAS unsigned char*)lds_raw;
    cg::grid_group grid = cg::this_grid();
    Ctx F;
    F.ap = nullptr; F.out = nullptr; F.ws = nullptr; F.rep = 0;
    F.tid = threadIdx.x; F.lane = F.tid & 63; F.wave = __builtin_amdgcn_readfirstlane(F.tid >> 6); F.G = gridDim.x; F.bid = blockIdx.x;
    const int lo = args.ph_lo, hi = args.ph_hi;
    if (lo < 0) grid.sync();
    volatile LAS unsigned* misc = (volatile LAS unsigned*)(lds + MISC_OFF);
    if (threadIdx.x < 16) misc[threadIdx.x] = 0u;
    __syncthreads();
    XcdBarrier xbar; xbar.bar = (unsigned*)(args.ws + WS_BAR); xbar.x = 0; xbar.st = misc;
    if (hi - lo > 1) xbar = xcd_barrier_post((unsigned*)(args.ws + WS_BAR), misc);
#define PH_BEGIN(k) if (lo <= (k) && (k) < hi) { { int t = threadIdx.x; asm volatile("" : "+v"(t)); F.tid = t; F.lane = t & 63; F.wave = __builtin_amdgcn_readfirstlane(t >> 6); \
          const __attribute__((address_space(4))) Args* ap = (const __attribute__((address_space(4))) Args*)__builtin_amdgcn_kernarg_segment_ptr(); \
          asm volatile("" : "+s"(ap)); F.ap = ap; F.ws = ap->ws; F.out = ap->out; } const float* mod = (const float*)(F.ws + WS_CTL); (void)mod;
#define PH_END(k) if ((k) + 1 < hi) xcd_barrier(xbar); }
#define REP(k) for (int rep_ = 0; (F.rep = rep_) < PH_REP[k]; ++rep_)
    PH_BEGIN(PH_PREP) REP(PH_PREP) { phase_gemv(F, lds); phase_prep(F, lds); } PH_END(PH_PREP)
    PH_BEGIN(PH_NORM_A0) REP(PH_NORM_A0) { norm_rows(F, FIN(0), FIN(2), MR, FIN(6), mod, mod + DM, mod + 2 * 12288, mod + 2 * 12288 + DM, (bf16_t*)(F.ws + WS_H)); } PH_END(PH_NORM_A0)
    PH_BEGIN(PH_G_IN0) REP(PH_G_IN0) { gemm_phase(F, lds, PH_G_IN0); } PH_END(PH_G_IN0)
    PH_BEGIN(PH_QKPOOL) REP(PH_QKPOOL) { phase_qkpool(F); } PH_END(PH_QKPOOL)
    PH_BEGIN(PH_ATTN) REP(PH_ATTN) { phase_attn(F, lds); } PH_END(PH_ATTN)
    PH_BEGIN(PH_G_OUT0) REP(PH_G_OUT0) { gemm_phase(F, lds, PH_G_OUT0); } PH_END(PH_G_OUT0)
    PH_BEGIN(PH_NORM_B0) REP(PH_NORM_B0) { norm_rows(F, F.out, F.out, NT, FIN(7), mod + 3 * DM, mod + 4 * DM, mod, mod, (bf16_t*)(F.ws + WS_H)); } PH_END(PH_NORM_B0)
    PH_BEGIN(PH_G_UP0) REP(PH_G_UP0) { gemm_phase(F, lds, PH_G_UP0); } PH_END(PH_G_UP0)
    PH_BEGIN(PH_CONV0) REP(PH_CONV0) { phase_conv(F, 0); } PH_END(PH_CONV0)
    PH_BEGIN(PH_G_DN0) REP(PH_G_DN0) { gemm_phase(F, lds, PH_G_DN0); } PH_END(PH_G_DN0)
    PH_BEGIN(PH_NORM_A1) REP(PH_NORM_A1) { norm_rows(F, F.out, F.out, NT, FIN(6) + DM, mod + 12288, mod + 12288 + DM, mod, mod, (bf16_t*)(F.ws + WS_H)); } PH_END(PH_NORM_A1)
    PH_BEGIN(PH_G_IN1) REP(PH_G_IN1) { gemm_phase(F, lds, PH_G_IN1); } PH_END(PH_G_IN1)
    PH_BEGIN(PH_G_F1) REP(PH_G_F1) { gemm_phase(F, lds, PH_G_F1); phase_vtn(F, lds); } PH_END(PH_G_F1)
    PH_BEGIN(PH_G_S1) REP(PH_G_S1) { gemm_phase(F, lds, PH_G_S1); } PH_END(PH_G_S1)
    PH_BEGIN(PH_G_S2) REP(PH_G_S2) { gemm_phase(F, lds, PH_G_S2); } PH_END(PH_G_S2)
    PH_BEGIN(PH_G_OUT1) REP(PH_G_OUT1) { gemm_phase(F, lds, PH_G_OUT1); } PH_END(PH_G_OUT1)
    PH_BEGIN(PH_NORM_B1) REP(PH_NORM_B1) { norm_rows(F, F.out, F.out, NT, FIN(7) + DM, mod + 12288 + 3 * DM, mod + 12288 + 4 * DM, mod, mod, (bf16_t*)(F.ws + WS_H)); } PH_END(PH_NORM_B1)
    PH_BEGIN(PH_G_UP1) REP(PH_G_UP1) { gemm_phase(F, lds, PH_G_UP1); } PH_END(PH_G_UP1)
    PH_BEGIN(PH_CONV1) REP(PH_CONV1) { phase_conv(F, 1); } PH_END(PH_CONV1)
    PH_BEGIN(PH_G_DN1) REP(PH_G_DN1) { gemm_phase(F, lds, PH_G_DN1); } PH_END(PH_G_DN1)
#undef PH_BEGIN
#undef PH_END
}

#ifndef MK_SPLIT
#define MK_SPLIT 0
#endif
extern "C" void kernel_launch(void* const* d_in, const int* in_sizes, int n_in, void* d_out, int out_size, void* d_ws, size_t ws_size, hipStream_t stream) {
    static int grid = 0;
    if (grid == 0) {
        if (n_in != 25 || out_size != NT * DM || ws_size < WS_END) { fprintf(stderr, "kernel_launch: unexpected problem (n_in %d out %d ws %zu)\n", n_in, out_size, ws_size); grid = -1; return; }
        int dev = 0, cus = 0, per_cu = 0;
        hipGetDevice(&dev); hipDeviceGetAttribute(&cus, hipDeviceAttributeMultiprocessorCount, dev);
        hipFuncSetAttribute((const void*)fwd_mega, hipFuncAttributeMaxDynamicSharedMemorySize, LDS_BYTES);
        hipOccupancyMaxActiveBlocksPerMultiprocessor(&per_cu, (const void*)fwd_mega, 512, LDS_BYTES);
        if (per_cu < 1) { fprintf(stderr, "kernel_launch: occupancy query says %d blocks per CU\n", per_cu); per_cu = 1; }
        grid = cus * 1;
        (void)hipGetLastError();
    }
    if (grid < 0) return;
    hipMemsetAsync((char*)d_ws + WS_BAR, 0, XCD_BAR_WORDS * 4, stream);
    Args a{};
    for (int i = 0; i < 25; ++i) a.in[i] = (const float*)d_in[i];
    a.out = (float*)d_out; a.ws = (unsigned char*)d_ws;
#if MK_SPLIT
    for (int ph = 0; ph < PH_COUNT; ++ph) {
        a.ph_lo = ph; a.ph_hi = ph + 1;
        hipLaunchKernelGGL(fwd_mega, dim3(grid), dim3(512), LDS_BYTES, stream, a);
    }
#else
    a.ph_lo = 0; a.ph_hi = PH_COUNT;
    void* kargs[] = {&a};
    hipError_t e = hipLaunchCooperativeKernel((const void*)fwd_mega, dim3(grid), dim3(512), kargs, LDS_BYTES, stream);
    if (e != hipSuccess) fprintf(stderr, "cooperative launch failed: %s (grid %d)\n", hipGetErrorString(e), grid);
#endif
}
```

```cpp
#include <hip/hip_runtime.h>
#include <hip/hip_cooperative_groups.h>
#include <cstdio>
#include <cstdint>
namespace cg = cooperative_groups;

#define LAS __attribute__((address_space(3)))
typedef unsigned short bf16_t;
typedef short bf16x8 __attribute__((ext_vector_type(8)));
typedef short s16x4 __attribute__((ext_vector_type(4)));
typedef float f32x4 __attribute__((ext_vector_type(4)));
typedef float f32x2 __attribute__((ext_vector_type(2)));
typedef unsigned u32x4 __attribute__((ext_vector_type(4)));
typedef unsigned u32x2 __attribute__((ext_vector_type(2)));

constexpr int NT = 8192, DM = 2048, LC = 256, MR = NT + LC;
constexpr int FF = 5632, FF2 = 11264;
constexpr float EPS = 1e-6f;
constexpr size_t MiB = 1u << 20;
constexpr size_t WS_CTL = 0, CTL_BYTES = 1 * MiB;
constexpr size_t WS_W_IN0 = 2 * MiB, WS_W_OUT0X = 12 * MiB, WS_W_OB0 = 20 * MiB, WS_W_POOL = 24 * MiB, WS_W_IN1 = 25 * MiB,
                 WS_W_OUT1X = 37 * MiB, WS_W_OB1 = 49 * MiB, WS_W_FO = 53 * MiB, WS_W_UP0 = 55 * MiB, WS_W_UP1 = 99 * MiB,
                 WS_W_DN0 = 143 * MiB, WS_W_DN1 = 165 * MiB, WS_W_SPBD = 187 * MiB, WS_W_CHD = 188 * MiB,
                 WS_W_A1 = 188 * MiB + 65536, WS_W_A2 = 188 * MiB + 262144, WS_TW = 188 * MiB + 524288;
constexpr size_t WS_H = 190 * MiB, WS_QB = 223 * MiB, WS_KB = 239 * MiB, WS_VT = 244 * MiB, WS_ZB = 249 * MiB, WS_CAT = 265 * MiB,
                 WS_U = 313 * MiB, WS_ACT = 489 * MiB, WS_YP = 313 * MiB  ,
                 WS_U1 = 577 * MiB, WS_GV = 593 * MiB, WS_PF = 609 * MiB, WS_VTN = 625 * MiB, WS_GT2 = 641 * MiB, WS_END = 673 * MiB;

enum { PH_PREP = 0, PH_NORM_A0, PH_G_IN0, PH_QKPOOL, PH_ATTN, PH_G_OUT0, PH_NORM_B0, PH_G_UP0, PH_CONV0, PH_G_DN0,
       PH_NORM_A1, PH_G_IN1, PH_G_F1, PH_G_S1, PH_G_S2, PH_G_OUT1, PH_NORM_B1, PH_G_UP1, PH_CONV1, PH_G_DN1, PH_COUNT };

constexpr int PH_REP[20] = {1, 1, 1, 1, 1, 1, 1, 1, 1, 1, 1, 1, 1, 1, 1, 1, 1, 1, 1, 1};
struct Args { const float* in[25]; float* out; unsigned char* ws; int ph_lo, ph_hi; };

struct Ctx {
    const __attribute__((address_space(4))) Args* ap; float* out; unsigned char* ws;
    int tid, lane, wave, G, bid, rep;
};
#define FIN(i) (F.ap->in[i])

__device__ __forceinline__ unsigned cvt_pk_bf16(float lo, float hi) { unsigned r; asm volatile("v_cvt_pk_bf16_f32 %0, %1, %2" : "=v"(r) : "v"(lo), "v"(hi)); return r; }
__device__ __forceinline__ float bf2f(bf16_t b) { return __uint_as_float(((unsigned)b) << 16); }
__device__ __forceinline__ float bflo(unsigned w) { return __uint_as_float(w << 16); }
__device__ __forceinline__ float bfhi(unsigned w) { return __uint_as_float(w & 0xffff0000u); }
__device__ __forceinline__ bf16_t f2bf(float f) { return (bf16_t)(cvt_pk_bf16(f, 0.f) & 0xffffu); }
__device__ __forceinline__ float wave_sum(float v) {
#pragma unroll
    for (int o = 1; o < 64; o <<= 1) v += __shfl_xor(v, o);
    return v;
}
__device__ __forceinline__ f32x2 gelu_pk(f32x2 v) {
    const f32x2 av = __builtin_elementwise_abs(v), d = av * 0.2316418882f + 1.0f;
    f32x2 t; t.x = __builtin_amdgcn_rcpf(d.x); t.y = __builtin_amdgcn_rcpf(d.y);
    f32x2 q = t * 0.5307027145f + (-0.7265760135f); q = q * t + 0.7107068705f; q = q * t + (-0.142248368f); q = q * t + 0.127414796f; q = q * t;
    const f32x2 s = (v * v) * (-0.72134752044f);
    f32x2 e; e.x = __builtin_amdgcn_exp2f(s.x); e.y = __builtin_amdgcn_exp2f(s.y);
    const f32x2 m = v * (q * e), r = v - m;
    f32x2 o; o.x = v.x < 0.f ? m.x : r.x; o.y = v.y < 0.f ? m.y : r.y; return o;
}

constexpr int BM = 256, BK = 64, HALF = 128, HTB = HALF * BK * 2, STAGE_BYTES = 8 * HTB, NXCD = 8, WGM = 8;
__device__ __forceinline__ int lds_byte(int r, int c) { const int st = (r >> 4) * 2 + (c >> 5), rr = r & 15, cc = c & 31, ob = rr * 64 + cc * 2; return st * 1024 + (ob ^ (((ob >> 9) & 1) << 5)); }
__device__ __forceinline__ void stage_rc(int b, int& R, int& C) { const int st = b / 1024, sb = b % 1024, swz = sb ^ (((sb >> 9) & 1) << 5); R = (st >> 1) * 16 + swz / 64; C = (st & 1) * 32 + (swz % 64) / 2; }
__device__ __forceinline__ int perm32(int rho) { const int n = rho >> 4, i = rho & 15; return 8 * (i >> 2) + 4 * n + (i & 3); }

struct GU { const char* A; const char* B; unsigned lda2, ldb2; int nt; int perm; unsigned hA, hB; };
enum { EK_BF16 = 0, EK_RES = 1, EK_GATE = 2, EK_TW = 3, EK_Z2 = 4, EK_CONV = 5 };
struct EP { int kind; bf16_t* O; unsigned ldc; unsigned hoff; int gelu; unsigned dup; unsigned choff; const float* base; float* outf; const float* vec; const bf16_t* U1p; const float* bias; };

__device__ __forceinline__ void tile_order(int L, int nM, int nN, int& pm, int& pn) {
    const int nwg = nM * nN; int wgid = L;
    { const int q = nwg / NXCD, r = nwg % NXCD, xcd = wgid % NXCD, off = wgid / NXCD; wgid = (xcd < r ? xcd * (q + 1) : r * (q + 1) + (xcd - r) * q) + off; }
    const int nig = WGM * nN, gid = wgid / nig, fm = gid * WGM, gsz = (nM - fm) < WGM ? (nM - fm) : WGM;
    pm = fm + ((wgid % nig) % gsz); pn = (wgid % nig) / gsz;
}

__device__ __forceinline__ int gemm_units(int ph) {
    switch (ph) {
        case PH_G_IN0: return 386;
        case PH_G_OUT0: return 256;
        case PH_G_UP0: case PH_G_UP1: return 33 * 44;
        case PH_G_DN0: case PH_G_DN1: return 256;
        case PH_G_IN1: return 384;
        case PH_G_F1: return 256;
        case PH_G_S1: return 256;
        case PH_G_S2: return 256;
        case PH_G_OUT1: return 256;
    }
    return 0;
}

__device__ __forceinline__ void unit_desc(const Ctx& F, int ph, int L, GU& u, EP& e) {
    unsigned char* ws = F.ws;
    e.kind = EK_BF16; e.O = nullptr; e.ldc = 0; e.hoff = 0; e.gelu = 0; e.dup = 0; e.choff = 128; u.hA = 0; u.hB = 0; e.base = nullptr; e.outf = nullptr; e.vec = nullptr; e.U1p = nullptr; e.bias = nullptr;
    u.perm = 1;
    const bf16_t* H = (const bf16_t*)(ws + WS_H);
    switch (ph) {
    case PH_G_IN0: {
        const bf16_t* W = (const bf16_t*)(ws + WS_W_IN0);
        u.lda2 = DM * 2; u.ldb2 = DM * 2; u.nt = DM / BK;
        if (L < 322) {
            int pm, pn;
            if (L < 320) tile_order(L, 32, 10, pm, pn); else { pm = 32; pn = 4 + (L - 320); }
            if (pn == 5) {
                u.A = (const char*)(W + (size_t)1280 * DM); u.B = (const char*)(H + (size_t)pm * 256 * DM);
                e.O = (bf16_t*)(ws + WS_VT) + pm * 256; e.ldc = MR;
            } else {
                u.A = (const char*)(H + (size_t)pm * 256 * DM); u.B = (const char*)(W + (size_t)pn * 256 * DM);
                if (pn < 4) { e.O = (bf16_t*)(ws + WS_QB) + (size_t)pm * 256 * 1024 + pn * 256; e.ldc = 1024; }
                else if (pn == 4) { e.O = (bf16_t*)(ws + WS_KB) + (size_t)pm * 256 * 256; e.ldc = 256; }
                else { e.O = (bf16_t*)(ws + WS_ZB) + (size_t)pm * 256 * 1024 + (pn - 6) * 256; e.ldc = 1024; }
            }
        } else if (L < 354) {
            const int f = L - 322, mo = f >> 2, g = f & 3;
            u.A = (const char*)((const bf16_t*)(ws + WS_W_OB0) + (size_t)mo * 256 * 1024 + g * 256); u.lda2 = 1024 * 2;
            u.B = (const char*)((const bf16_t*)(ws + WS_W_POOL) + (size_t)g * 65536); u.ldb2 = 256 * 2; u.nt = 4;
            e.O = (bf16_t*)(ws + WS_W_OUT0X) + (size_t)mo * 256 * 2048 + 1024 + g * 256; e.ldc = 2048;
        } else {
            const int f = L - 354, mo = f >> 2, ct = f & 3;
            u.A = (const char*)((const bf16_t*)(ws + WS_W_OB1) + (size_t)mo * 256 * 1024); u.lda2 = 1024 * 2;
            u.B = (const char*)((const bf16_t*)(ws + WS_W_FO) + (size_t)ct * 256 * 1024); u.ldb2 = 1024 * 2; u.nt = 16;
            e.O = (bf16_t*)(ws + WS_W_OUT1X) + (size_t)mo * 256 * 2048 + 1024 + ct * 256; e.ldc = 2048;
        }
        e.hoff = 128u * e.ldc;
    } break;
    case PH_G_OUT0: case PH_G_OUT1: {
        int pm, pn; tile_order(L, 32, 8, pm, pn);
        const int l1 = (ph == PH_G_OUT1); const int kd = 2048;
        u.A = (const char*)((const bf16_t*)(ws + WS_CAT) + (size_t)pm * 256 * kd); u.lda2 = kd * 2;
        u.B = (const char*)((const bf16_t*)(ws + (l1 ? WS_W_OUT1X : WS_W_OUT0X)) + (size_t)pn * 256 * kd); u.ldb2 = kd * 2; u.nt = kd / BK; u.perm = 0;
        e.kind = EK_RES; e.base = (l1 ? (const float*)F.out : FIN(0)) + (size_t)pm * 256 * DM + pn * 256; e.outf = F.out + (size_t)pm * 256 * DM + pn * 256;
        e.vec = (const float*)(ws + WS_CTL) + l1 * 12288 + 2 * DM + pn * 256;
    } break;
    case PH_G_UP0: case PH_G_UP1: {
        int pm, pn; tile_order(L, 33, 44, pm, pn);
        const int l1 = (ph == PH_G_UP1);
        u.A = (const char*)(H + ((long)254 * pm - 1) * DM); u.lda2 = DM * 2;
        u.B = (const char*)((const bf16_t*)(ws + (l1 ? WS_W_UP1 : WS_W_UP0)) + (size_t)pn * 128 * DM); u.ldb2 = DM * 2; u.hB = (unsigned)FF * DM * 2u; u.nt = DM / BK;
        e.kind = EK_CONV; e.O = (bf16_t*)(ws + WS_ACT) + pn * 128; e.ldc = FF; e.dup = (unsigned)(254 * pm - 1);
        e.base = FIN(22) + (size_t)l1 * 3 * FF2 + pn * 128; e.vec = FIN(23) + (size_t)l1 * FF2 + pn * 128;
    } break;
    case PH_G_DN0: case PH_G_DN1: {
        int pm, pn; tile_order(L, 32, 8, pm, pn);
        const int l1 = (ph == PH_G_DN1);
        u.A = (const char*)((const bf16_t*)(ws + WS_ACT) + (size_t)pm * 256 * FF); u.lda2 = FF * 2;
        u.B = (const char*)((const bf16_t*)(ws + (l1 ? WS_W_DN1 : WS_W_DN0)) + (size_t)pn * 256 * FF); u.ldb2 = FF * 2; u.nt = FF / BK; u.perm = 0;
        e.kind = EK_RES; e.base = F.out + (size_t)pm * 256 * DM + pn * 256; e.outf = F.out + (size_t)pm * 256 * DM + pn * 256;
        e.vec = (const float*)(ws + WS_CTL) + l1 * 12288 + 5 * DM + pn * 256;
    } break;
    case PH_G_IN1: {
        int pm, pn; tile_order(L, 32, 12, pm, pn);
        u.A = (const char*)(H + (size_t)pm * 256 * DM); u.lda2 = DM * 2;
        u.B = (const char*)((const bf16_t*)(ws + WS_W_IN1) + (size_t)pn * 256 * DM); u.ldb2 = DM * 2; u.nt = DM / BK;
        const size_t dst = pn < 4 ? WS_U1 : (pn < 8 ? WS_GV : WS_PF);
        e.O = (bf16_t*)(ws + dst) + (size_t)pm * 256 * 1024 + (pn & 3) * 256; e.ldc = 1024; e.hoff = 128u * 1024; e.gelu = pn < 8;
    } break;
    case PH_G_F1: {
        const int tt = L >> 3, g = L & 7, a0 = 2 * tt;
        u.A = (const char*)(ws + WS_W_CHD); u.lda2 = 128 * 2;
        u.B = (const char*)((const bf16_t*)(ws + WS_PF) + (size_t)a0 * 1024 + g * 128); u.ldb2 = 64 * 1024 * 2; u.hB = 1024 * 2; u.nt = 2;
        e.O = (bf16_t*)(ws + WS_GT2) + (size_t)g * 128 * 16384 + a0 * 256; e.ldc = 16384; e.hoff = 128; e.choff = 256;
    } break;
    case PH_G_S1: {
        u.A = (const char*)(ws + WS_W_A1); u.lda2 = 256 * 2;
        u.B = (const char*)((const bf16_t*)(ws + WS_GT2) + (size_t)L * 256 * 256); u.ldb2 = 256 * 2; u.nt = 4;
        e.kind = EK_TW; e.O = (bf16_t*)(ws + WS_YP) + (size_t)(L * 4) * 16384; e.bias = (const float*)(ws + WS_TW);
    } break;
    case PH_G_S2: {
        if (L < 128) {
            const int dq = L >> 2, ct = L & 3;
            u.A = (const char*)(ws + WS_W_A2); u.lda2 = 512 * 2;
            u.B = (const char*)((const bf16_t*)(ws + WS_YP) + (size_t)ct * 256 * 16384 + dq * 512); u.ldb2 = 16384 * 2; u.nt = 8;
            e.kind = EK_Z2; e.O = (bf16_t*)(ws + WS_CAT) + (size_t)(4 * dq) * 2048 + 1024 + ct * 256; e.ldc = 2048;
        } else {
            const int f = L - 128, kp = f >> 2, g = f & 3;
            u.A = (const char*)((const bf16_t*)(ws + WS_W_SPBD) + (size_t)g * 65536); u.lda2 = 256 * 2;
            u.B = (const char*)((const bf16_t*)(ws + WS_VTN) + (size_t)g * 256 * 8192 + kp * 256); u.ldb2 = 8192 * 2; u.nt = 4;
            e.kind = EK_GATE; e.O = (bf16_t*)(ws + WS_CAT) + (size_t)kp * 256 * 2048 + g * 256; e.ldc = 2048; e.hoff = 128u * 2048;
            e.U1p = (const bf16_t*)(ws + WS_U1) + (size_t)kp * 256 * 1024 + g * 256; e.bias = FIN(18) + g * 128;
        }
    } break;
    default: u.A = nullptr; u.B = nullptr; u.lda2 = 0; u.ldb2 = 0; u.nt = 2; break;
    }
    if (u.hA == 0) u.hA = 128u * u.lda2;
    if (u.hB == 0) u.hB = 128u * u.ldb2;
}

constexpr size_t WS_TAB = 1 * MiB;
__device__ __forceinline__ int tab_off(int ph) {
    switch (ph) {
        case PH_G_IN0: return 0; case PH_G_OUT0: return 386; case PH_G_UP0: return 642; case PH_G_DN0: return 2094; case PH_G_IN1: return 2350;
        case PH_G_F1: return 2734; case PH_G_S1: return 2990; case PH_G_S2: return 3246; case PH_G_OUT1: return 3502; case PH_G_UP1: return 3758; case PH_G_DN1: return 5210;
    }
    return 0;
}
constexpr int TAB_UNITS = 5466;
__device__ __forceinline__ void store_rec(unsigned long long* r, const GU& u, const EP& e) {
    r[0] = (unsigned long long)u.A; r[1] = (unsigned long long)u.B; r[2] = (unsigned long long)u.lda2 | ((unsigned long long)u.ldb2 << 32);
    r[3] = (unsigned long long)(unsigned)u.nt | ((unsigned long long)(unsigned)u.perm << 32);
    r[4] = (unsigned long long)(unsigned)e.kind | ((unsigned long long)(unsigned)e.gelu << 32);
    r[5] = e.kind == EK_RES ? (unsigned long long)e.outf : (unsigned long long)e.O;
    r[6] = (unsigned long long)e.ldc | ((unsigned long long)e.hoff << 32);
    r[7] = (unsigned long long)e.dup | ((unsigned long long)e.choff << 32);
    r[10] = (unsigned long long)u.hA | ((unsigned long long)u.hB << 32);
    r[8] = (e.kind == EK_RES || e.kind == EK_CONV) ? (unsigned long long)e.base : (unsigned long long)e.U1p;
    r[9] = (e.kind == EK_RES || e.kind == EK_CONV) ? (unsigned long long)e.vec : (unsigned long long)e.bias;
}
__device__ __forceinline__ unsigned ldu(const unsigned* p) { return (unsigned)__builtin_amdgcn_readfirstlane((int)__hip_atomic_load(p, __ATOMIC_RELAXED, __HIP_MEMORY_SCOPE_AGENT)); }
__device__ __forceinline__ unsigned long long ldu64(const unsigned* p) { return (unsigned long long)ldu(p) | ((unsigned long long)ldu(p + 1) << 32); }
__device__ __forceinline__ void load_gu(const unsigned* r, GU& u) {
    u.A = (const char*)ldu64(r); u.B = (const char*)ldu64(r + 2); u.lda2 = ldu(r + 4); u.ldb2 = ldu(r + 5); u.nt = (int)ldu(r + 6); u.perm = (int)ldu(r + 7); u.hA = ldu(r + 20); u.hB = ldu(r + 21);
}
__device__ __forceinline__ void load_ep(const unsigned* r, EP& e) {
    e.kind = (int)ldu(r + 8); e.gelu = (int)ldu(r + 9);
    const unsigned long long p5 = ldu64(r + 10); e.O = (bf16_t*)p5; e.outf = (float*)p5;
    e.ldc = ldu(r + 12); e.hoff = ldu(r + 13); e.dup = ldu(r + 14); e.choff = ldu(r + 15);
    const unsigned long long p8 = ldu64(r + 16), p9 = ldu64(r + 18);
    e.base = (const float*)p8; e.U1p = (const bf16_t*)p8; e.vec = (const float*)p9; e.bias = (const float*)p9;
}

__device__ __forceinline__ bool kind_ok(int ph, int kind) {
    const bool res = (ph == PH_G_OUT0) | (ph == PH_G_OUT1) | (ph == PH_G_DN0) | (ph == PH_G_DN1);
    if (kind == EK_RES) return res;
    if (kind == EK_GATE || kind == EK_Z2) return ph == PH_G_S2;
    if (kind == EK_TW) return ph == PH_G_S1;
    if (kind == EK_CONV) return ph == PH_G_UP0 || ph == PH_G_UP1;
    return !res && ph != PH_G_S1 && ph != PH_G_S2 && ph != PH_G_UP0 && ph != PH_G_UP1;
}
constexpr int HALO_OFF = 8 * 64 * 65 * 4 + 2048;
__device__ __forceinline__ void run_epilogue(const Ctx& F, int ph, const EP& e, f32x4 (&acc)[2][2][4][2], int wr, int wc, int fr, int fq, LAS unsigned char* lds) {
    asm volatile("" : "+v"(fr), "+v"(fq));
    if (kind_ok(ph, EK_BF16)) {
        const unsigned col0 = wc * 32 + 8 * fq;
#pragma unroll
        for (int ai = 0; ai < 2; ++ai)
#pragma unroll
            for (int m = 0; m < 4; ++m) {
                bf16_t* rowp = e.O + (size_t)ai * e.hoff + (size_t)(wr * 64 + m * 16 + fr) * e.ldc + col0;
#pragma unroll
                for (int bj = 0; bj < 2; ++bj) {
                    f32x4 v0 = acc[ai][bj][m][0], v1 = acc[ai][bj][m][1];
                    if (e.gelu) { f32x2 a = gelu_pk((f32x2){v0[0], v0[1]}), b = gelu_pk((f32x2){v0[2], v0[3]}), c = gelu_pk((f32x2){v1[0], v1[1]}), d = gelu_pk((f32x2){v1[2], v1[3]});
                        v0 = (f32x4){a.x, a.y, b.x, b.y}; v1 = (f32x4){c.x, c.y, d.x, d.y}; }
                    u32x4 w; w.x = cvt_pk_bf16(v0[0], v0[1]); w.y = cvt_pk_bf16(v0[2], v0[3]); w.z = cvt_pk_bf16(v1[0], v1[1]); w.w = cvt_pk_bf16(v1[2], v1[3]);
                    *(u32x4*)(rowp + (size_t)bj * e.choff) = w;
                    if (e.dup) *(u32x4*)(rowp + (size_t)bj * e.choff + e.dup) = w;
                }
            }
    } else if (kind_ok(ph, EK_RES)) {
        const int col0 = wc * 32 + 4 * fq;
#pragma unroll
        for (int bj = 0; bj < 2; ++bj)
#pragma unroll
            for (int n = 0; n < 2; ++n) {
                f32x4 bs[2][4];
                const f32x4 mv = *(const f32x4*)(e.vec + col0 + bj * HALF + n * 16);
#pragma unroll
                for (int ai = 0; ai < 2; ++ai)
#pragma unroll
                    for (int m = 0; m < 4; ++m) bs[ai][m] = *(const f32x4*)(e.base + (size_t)(ai * HALF + wr * 64 + m * 16 + fr) * DM + col0 + bj * HALF + n * 16);
                asm volatile("" ::: "memory");
#pragma unroll
                for (int ai = 0; ai < 2; ++ai)
#pragma unroll
                    for (int m = 0; m < 4; ++m) {
                        const size_t off = (size_t)(ai * HALF + wr * 64 + m * 16 + fr) * DM + col0 + bj * HALF + n * 16;
                        float* dst = e.outf;
                        if (PH_REP[ph] > 1 && F.rep + 1 < PH_REP[ph]) dst = (float*)(F.ws + WS_U) + (e.outf - F.out);
                        *(f32x4*)(dst + off) = bs[ai][m] + mv * acc[ai][bj][m][n];
                    }
                asm volatile("" ::: "memory");
            }
    } else if (kind_ok(ph, EK_GATE) && e.kind == EK_GATE) {
        const unsigned col0 = wc * 32 + 8 * fq;
#pragma unroll
        for (int ai = 0; ai < 2; ++ai) {
            u32x4 uu[4][2]; float bsv[4];
#pragma unroll
            for (int m = 0; m < 4; ++m) {
                const int r = wr * 64 + m * 16 + fr;
                bsv[m] = e.bias[r];
                const bf16_t* up = e.U1p + (size_t)(ai * HALF + r) * 1024 + col0;
                uu[m][0] = *(const u32x4*)up; uu[m][1] = *(const u32x4*)(up + HALF);
            }
            asm volatile("" ::: "memory");
#pragma unroll
            for (int m = 0; m < 4; ++m) {
                const int r = wr * 64 + m * 16 + fr;
                bf16_t* rowp = e.O + (size_t)ai * e.hoff + (size_t)r * e.ldc + col0;
#pragma unroll
                for (int bj = 0; bj < 2; ++bj) {
                    const u32x4 u4 = uu[m][bj];
                    const f32x4 v0 = acc[ai][bj][m][0] + bsv[m], v1 = acc[ai][bj][m][1] + bsv[m];
                    u32x4 w;
                    w.x = cvt_pk_bf16(bflo(u4.x) * v0[0], bfhi(u4.x) * v0[1]); w.y = cvt_pk_bf16(bflo(u4.y) * v0[2], bfhi(u4.y) * v0[3]);
                    w.z = cvt_pk_bf16(bflo(u4.z) * v1[0], bfhi(u4.z) * v1[1]); w.w = cvt_pk_bf16(bflo(u4.w) * v1[2], bfhi(u4.w) * v1[3]);
                    *(u32x4*)(rowp + bj * HALF) = w;
                }
            }
            asm volatile("" ::: "memory");
        }
    } else if (kind_ok(ph, EK_Z2) && e.kind == EK_Z2) {
        const unsigned col0 = wc * 32 + 8 * fq;
#pragma unroll
        for (int ai = 0; ai < 2; ++ai)
#pragma unroll
            for (int m = 0; m < 4; ++m) {
                bf16_t* rowp = e.O + (size_t)((m * 16 + fr) * 128 + 2 * ai + wr) * e.ldc + col0;
#pragma unroll
                for (int bj = 0; bj < 2; ++bj) {
                    const f32x4 v0 = acc[ai][bj][m][0], v1 = acc[ai][bj][m][1];
                    u32x4 w; w.x = cvt_pk_bf16(v0[0], v0[1]); w.y = cvt_pk_bf16(v0[2], v0[3]); w.z = cvt_pk_bf16(v1[0], v1[1]); w.w = cvt_pk_bf16(v1[2], v1[3]);
                    *(u32x4*)(rowp + bj * HALF) = w;
                }
            }
    } else if (kind_ok(ph, EK_CONV)) {
        const int tb = (int)e.dup;
        LAS float* halo = (LAS float*)(lds + HALO_OFF);
        const int lane = wr * 0 + (fq << 4 | fr);
        if (tb < 0 || tb + 255 >= NT) {
#pragma unroll
            for (int ai = 0; ai < 2; ++ai)
#pragma unroll
                for (int m = 0; m < 4; ++m) { const int tok = tb + ai * HALF + wr * 64 + m * 16 + fr;
                    if (tok < 0 || tok >= NT) {
#pragma unroll
                        for (int bj = 0; bj < 2; ++bj)
#pragma unroll
                            for (int n = 0; n < 2; ++n) acc[ai][bj][m][n] = (f32x4){0.f, 0.f, 0.f, 0.f}; } }
        }
        const int hcol = 32 * wc + 8 * fq;
#pragma unroll
        for (int ai = 0; ai < 2; ++ai) {
            const int blk = 2 * ai + wr;
            if (fr == 0) {
#pragma unroll
                for (int bj = 0; bj < 2; ++bj)
#pragma unroll
                    for (int n = 0; n < 2; ++n) *(LAS f32x4*)(halo + (blk * 2 + 0) * 256 + bj * HALF + hcol + 4 * n) = acc[ai][bj][0][n]; }
            if (fr == 15) {
#pragma unroll
                for (int bj = 0; bj < 2; ++bj)
#pragma unroll
                    for (int n = 0; n < 2; ++n) *(LAS f32x4*)(halo + (blk * 2 + 1) * 256 + bj * HALF + hcol + 4 * n) = acc[ai][bj][3][n]; }
        }
        asm volatile("s_waitcnt lgkmcnt(0)" ::: "memory"); __builtin_amdgcn_s_barrier(); asm volatile("" ::: "memory");
        const int src_up = ((lane & 48) | ((fr + 15) & 15)) * 4, src_dn = ((lane & 48) | ((fr + 1) & 15)) * 4;
        const float* cw = e.base; const float* cb = e.vec;
#pragma unroll
        for (int ai = 0; ai < 2; ++ai) {
            const int blk = 2 * ai + wr;
            unsigned outs[4][4];
#pragma unroll
            for (int n = 0; n < 2; ++n) {
                const int col = hcol + 4 * n;
                f32x4 w[2][3], bb[2], uph[2], dnh[2];
#pragma unroll
                for (int bj = 0; bj < 2; ++bj) {
#pragma unroll
                    for (int t = 0; t < 3; ++t) w[bj][t] = *(const f32x4*)(cw + (size_t)t * FF2 + bj * FF + col);
                    bb[bj] = *(const f32x4*)(cb + bj * FF + col);
                    uph[bj] = blk > 0 ? *(const LAS f32x4*)(halo + ((blk - 1) * 2 + 1) * 256 + bj * HALF + col) : (f32x4){0.f, 0.f, 0.f, 0.f};
                    dnh[bj] = blk < 3 ? *(const LAS f32x4*)(halo + ((blk + 1) * 2 + 0) * 256 + bj * HALF + col) : (f32x4){0.f, 0.f, 0.f, 0.f};
                }
#pragma unroll
                for (int jp = 0; jp < 2; ++jp) {
                    float cv[2][4][2];
#pragma unroll
                    for (int bj = 0; bj < 2; ++bj)
#pragma unroll
                        for (int jj = 0; jj < 2; ++jj) { const int j = 2 * jp + jj;
#pragma unroll
                            for (int m = 0; m < 4; ++m) {
                                const float cur = acc[ai][bj][m][n][j];
                                const float prev = m == 0 ? uph[bj][j] : acc[ai][bj][m == 0 ? 0 : m - 1][n][j];
                                const float next = m == 3 ? dnh[bj][j] : acc[ai][bj][m == 3 ? 3 : m + 1][n][j];
                                const float xs = fr == 15 ? prev : cur, ys = fr == 0 ? next : cur;
                                const float up = __int_as_float(__builtin_amdgcn_ds_bpermute(src_up, __float_as_int(xs)));
                                const float dn = __int_as_float(__builtin_amdgcn_ds_bpermute(src_dn, __float_as_int(ys)));
                                cv[bj][m][jj] = w[bj][0][j] * up + w[bj][1][j] * cur + w[bj][2][j] * dn + bb[bj][j];
                            } }
#pragma unroll
                    for (int m = 0; m < 4; ++m) {
                        const float g0 = cv[0][m][0], g1 = cv[0][m][1];
                        outs[m][2 * n + jp] = cvt_pk_bf16(g0 / (1.f + __expf(-g0)) * cv[1][m][0], g1 / (1.f + __expf(-g1)) * cv[1][m][1]);
                    }
                }
            }
#pragma unroll
            for (int m = 0; m < 4; ++m) {
                const int r = ai * HALF + wr * 64 + m * 16 + fr, tok = tb + r;
                if (r >= 1 && r <= 254 && tok < NT) { u32x4 o; o.x = outs[m][0]; o.y = outs[m][1]; o.z = outs[m][2]; o.w = outs[m][3]; *(u32x4*)(e.O + (size_t)tok * e.ldc + hcol) = o; }
            }
        }
    } else if (kind_ok(ph, EK_TW)) {
        const int a0 = 32 * (wc & 1) + 8 * fq;
        const float* twc = e.bias; const float* tws = e.bias + 8192;
#pragma unroll
        for (int m = 0; m < 4; ++m) {
            const int d = wr * 64 + m * 16 + fr;
            const f32x4 c0 = *(const f32x4*)(twc + d * 64 + a0), c1 = *(const f32x4*)(twc + d * 64 + a0 + 4);
            const f32x4 s0 = *(const f32x4*)(tws + d * 64 + a0), s1 = *(const f32x4*)(tws + d * 64 + a0 + 4);
#pragma unroll
            for (int bj = 0; bj < 2; ++bj) {
                const f32x4 r0 = acc[0][bj][m][0], r1 = acc[0][bj][m][1], i0 = acc[1][bj][m][0], i1 = acc[1][bj][m][1];
                const f32x4 yr0 = r0 * c0 + i0 * s0, yr1 = r1 * c1 + i1 * s1, yi0 = i0 * c0 - r0 * s0, yi1 = i1 * c1 - r1 * s1;
                bf16_t* p = e.O + (size_t)(2 * bj + (wc >> 1)) * 16384 + d * 128 + a0;
                u32x4 w; w.x = cvt_pk_bf16(yr0[0], yr0[1]); w.y = cvt_pk_bf16(yr0[2], yr0[3]); w.z = cvt_pk_bf16(yr1[0], yr1[1]); w.w = cvt_pk_bf16(yr1[2], yr1[3]);
                *(u32x4*)p = w;
                w.x = cvt_pk_bf16(yi0[0], yi0[1]); w.y = cvt_pk_bf16(yi0[2], yi0[3]); w.z = cvt_pk_bf16(yi1[0], yi1[1]); w.w = cvt_pk_bf16(yi1[2], yi1[3]);
                *(u32x4*)(p + 64) = w;
            }
        }
    }
}

__device__ __forceinline__ void filler_items(const Ctx& F, LAS unsigned char* lds, int ph, int first_idle);
__device__ __forceinline__ void gemm_phase(const Ctx& F, LAS unsigned char* lds, int ph) {
    const int tid = F.tid, wid = F.wave, lane = F.lane, wr = wid >> 2, wc = wid & 3, fr = lane & 15, fq = lane >> 4;
    const int nunits = gemm_units(ph);
    int Rr, Cc; stage_rc(tid * 16, Rr, Cc);
    const unsigned Ra = (unsigned)Rr, Rp = (unsigned)((Rr & ~31) + perm32(Rr & 31)), C2 = (unsigned)Cc * 2u;
    const unsigned ldsw = (unsigned)wid * 1024u;
    const int aoff = lds_byte(wr * 64 + fr, fq * 8), boff = lds_byte(wc * 32 + fr, fq * 8);
#define PG8_SA(b, h) (((b) * 2 + (h)) * HTB)
#define PG8_SB(b, h) ((4 + (b) * 2 + (h)) * HTB)
#define PG8_STAGE(bufoff, gbase, Rv, ld2) do { const unsigned _vo = (Rv) * (ld2) + C2; const char* _g = (gbase); \
        __builtin_amdgcn_global_load_lds((const unsigned*)(_g + _vo), (LAS unsigned*)(lds + (bufoff) + ldsw), 16, 0, 0); \
        __builtin_amdgcn_global_load_lds((const unsigned*)(_g + (size_t)64 * (ld2) + _vo), (LAS unsigned*)(lds + (bufoff) + ldsw + 8192), 16, 0, 0); } while (0)
#define PG8_LDA(dst, b, h) do { _Pragma("unroll") for (int m = 0; m < 4; ++m) _Pragma("unroll") for (int k = 0; k < 2; ++k) dst[m][k] = *(const LAS bf16x8*)(lds + PG8_SA(b, h) + aoff + m * 2048 + k * 1024); } while (0)
#define PG8_LDB(dst, b, h) do { _Pragma("unroll") for (int n = 0; n < 2; ++n) _Pragma("unroll") for (int k = 0; k < 2; ++k) dst[n][k] = *(const LAS bf16x8*)(lds + PG8_SB(b, h) + boff + n * 2048 + k * 1024); } while (0)
#define PG8_MMA(ai, bj, At, Bt) do { __builtin_amdgcn_s_setprio(1); _Pragma("unroll") for (int m = 0; m < 4; ++m) _Pragma("unroll") for (int n = 0; n < 2; ++n) _Pragma("unroll") for (int k = 0; k < 2; ++k) \
        acc[ai][bj][m][n] = __builtin_amdgcn_mfma_f32_16x16x32_bf16(Bt[n][k], At[m][k], acc[ai][bj][m][n], 0, 0, 0); __builtin_amdgcn_s_setprio(0); } while (0)
#define PG8_WAIT_V(n) asm volatile("s_waitcnt vmcnt(" #n ")" ::: "memory")
#define PG8_WAIT_L(n) asm volatile("s_waitcnt lgkmcnt(" #n ")" ::: "memory")
#define PG8_BAR __builtin_amdgcn_s_barrier()
#define PG8_SCHED __builtin_amdgcn_sched_barrier(0)
    int L = F.bid;
    if (L >= nunits) return;
    const unsigned* tab = (const unsigned*)(F.ws + WS_TAB) + (size_t)tab_off(ph) * 32;
    GU cur;
    load_gu(tab + (size_t)L * 32, cur);
    f32x4 acc[2][2][4][2];
#pragma unroll
    for (int a = 0; a < 2; ++a)
#pragma unroll
        for (int b = 0; b < 2; ++b)
#pragma unroll
            for (int m = 0; m < 4; ++m)
#pragma unroll
                for (int n = 0; n < 2; ++n) acc[a][b][m][n] = (f32x4){0.f, 0.f, 0.f, 0.f};
    bf16x8 At[4][2], B0[2][2], B1[2][2];
    const size_t kstep = (size_t)(BK * 2);
    {
        const unsigned Rb = cur.perm ? Rp : Ra; const size_t hA = cur.hA, hB = cur.hB;
        PG8_STAGE(PG8_SB(0, 0), cur.B, Rb, cur.ldb2); PG8_STAGE(PG8_SB(0, 1), cur.B + hB, Rb, cur.ldb2); PG8_STAGE(PG8_SA(0, 0), cur.A, Ra, cur.lda2); PG8_STAGE(PG8_SA(0, 1), cur.A + hA, Ra, cur.lda2);
        if (wr == 1) PG8_BAR;
        PG8_WAIT_V(2); PG8_BAR;
        PG8_STAGE(PG8_SB(1, 0), cur.B + kstep, Rb, cur.ldb2); PG8_STAGE(PG8_SA(1, 0), cur.A + kstep, Ra, cur.lda2); PG8_STAGE(PG8_SB(1, 1), cur.B + hB + kstep, Rb, cur.ldb2);
        PG8_WAIT_V(6); PG8_BAR;
    }
    for (;;) {
        const int Ln = L + F.G; const bool has_next = Ln < nunits;
        const char* cA = cur.A; const char* cB = cur.B; const int nt = cur.nt;
        const size_t hAc = cur.hA;
        for (int t = 0; t < nt; t += 2) {
            const bool last = (t == nt - 2);
            const char* a1 = cA + (size_t)(t + 1) * kstep;
            const char* a2 = cA + (size_t)(t + 2) * kstep; const char* b2 = cB + (size_t)(t + 2) * kstep;
            unsigned la2 = cur.lda2, lb2 = cur.ldb2; int pm2 = cur.perm; size_t hA2 = cur.hA, hB2 = cur.hB;
            if (last) { GU n2 = cur; if (has_next) load_gu(tab + (size_t)Ln * 32, n2); a2 = n2.A; b2 = n2.B; la2 = n2.lda2; lb2 = n2.ldb2; pm2 = n2.perm; hA2 = n2.hA; hB2 = n2.hB; }
            const unsigned Rb2 = pm2 ? Rp : Ra;
            const char* a3 = a2 + kstep; const char* b3 = b2 + kstep;
            PG8_LDB(B0, 0, 0); PG8_LDB(B1, 0, 1); PG8_SCHED; PG8_LDA(At, 0, 0); PG8_STAGE(PG8_SA(1, 1), a1 + hAc, Ra, cur.lda2);
            PG8_WAIT_V(8); PG8_WAIT_L(0); PG8_BAR; PG8_MMA(0, 0, At, B0); PG8_MMA(0, 1, At, B1); PG8_BAR; PG8_SCHED;
            PG8_LDA(At, 0, 1); PG8_STAGE(PG8_SB(0, 0), b2, Rb2, lb2); PG8_STAGE(PG8_SB(0, 1), b2 + hB2, Rb2, lb2); PG8_STAGE(PG8_SA(0, 0), a2, Ra, la2);
            PG8_WAIT_V(8); PG8_WAIT_L(0); PG8_BAR; PG8_MMA(1, 0, At, B0); PG8_MMA(1, 1, At, B1); PG8_BAR; PG8_SCHED;
            PG8_LDB(B0, 1, 0); PG8_LDB(B1, 1, 1); PG8_SCHED; PG8_LDA(At, 1, 0); PG8_STAGE(PG8_SA(0, 1), a2 + hA2, Ra, la2);
            PG8_WAIT_V(8); PG8_WAIT_L(0); PG8_BAR; PG8_MMA(0, 0, At, B0); PG8_MMA(0, 1, At, B1); PG8_BAR; PG8_SCHED;
            PG8_LDA(At, 1, 1); PG8_STAGE(PG8_SB(1, 0), b3, Rb2, lb2); PG8_STAGE(PG8_SB(1, 1), b3 + hB2, Rb2, lb2); PG8_STAGE(PG8_SA(1, 0), a3, Ra, la2);
            PG8_WAIT_V(8); PG8_WAIT_L(0); PG8_BAR; PG8_MMA(1, 0, At, B0); PG8_MMA(1, 1, At, B1); PG8_BAR; PG8_SCHED;
        }
        if (wr == 0) PG8_BAR;
        { EP ce; load_ep(tab + (size_t)L * 32, ce); run_epilogue(F, ph, ce, acc, wr, wc, fr, fq, lds); }
        if (!has_next) break;
#pragma unroll
        for (int a = 0; a < 2; ++a)
#pragma unroll
            for (int b = 0; b < 2; ++b)
#pragma unroll
                for (int m = 0; m < 4; ++m)
#pragma unroll
                    for (int n = 0; n < 2; ++n) acc[a][b][m][n] = (f32x4){0.f, 0.f, 0.f, 0.f};
        L = Ln; load_gu(tab + (size_t)L * 32, cur);
        if (wr == 1) PG8_BAR;
    }
    PG8_WAIT_V(0);
    PG8_BAR;
    if (ph == PH_G_IN0 && F.bid >= 130) filler_items(F, lds, ph, 130);
    if (ph == PH_G_IN1 && F.bid >= 128) filler_items(F, lds, ph, 128);
    if ((ph == PH_G_UP0 || ph == PH_G_UP1) && F.bid >= 172) filler_items(F, lds, ph, 172);
#undef PG8_SA
#undef PG8_SB
#undef PG8_STAGE
#undef PG8_LDA
#undef PG8_LDB
#undef PG8_MMA
#undef PG8_WAIT_V
#undef PG8_WAIT_L
#undef PG8_BAR
#undef PG8_SCHED
}

constexpr int TR_SCR = 64 * 65 * 4;
struct TJ { const float* W; int ldw; bf16_t* WT; int ldt; int k0, n0; };
constexpr int TR_IUP = 32 * 176, TR_IDN = 88 * 32, TR_IIN1 = 32 * 48, TR_I0 = 32 * 40, TR_I1 = 16 * 32;
__device__ __forceinline__ TJ tr_decode(const Ctx& F, int list, int it) {
    unsigned char* ws = F.ws; TJ j; int nblk;
    if (list == 0) {
        if (it < TR_I0) { j.W = FIN(8); j.ldw = 2560; nblk = 40; j.WT = (bf16_t*)(ws + WS_W_IN0); j.ldt = 2048; }
        else if ((it -= TR_I0) < TR_I1) { j.W = FIN(14); j.ldw = 2048; nblk = 32; j.WT = (bf16_t*)(ws + WS_W_OUT0X); j.ldt = 2048; }
        else if ((it -= TR_I1) < TR_I1) { j.W = FIN(14) + (size_t)1024 * 2048; j.ldw = 2048; nblk = 32; j.WT = (bf16_t*)(ws + WS_W_OB0); j.ldt = 1024; }
        else if ((it -= TR_I1) < TR_I1) { j.W = FIN(20); j.ldw = 2048; nblk = 32; j.WT = (bf16_t*)(ws + WS_W_OUT1X); j.ldt = 2048; }
        else { it -= TR_I1; j.W = FIN(20) + (size_t)1024 * 2048; j.ldw = 2048; nblk = 32; j.WT = (bf16_t*)(ws + WS_W_OB1); j.ldt = 1024; }
    } else if (list == 1) { j.W = FIN(21); j.ldw = FF2; nblk = 176; j.WT = (bf16_t*)(ws + WS_W_UP0); j.ldt = 2048; }
    else if (list == 2) {
        if (it < TR_IDN) { j.W = FIN(24); j.ldw = 2048; nblk = 32; j.WT = (bf16_t*)(ws + WS_W_DN0); j.ldt = FF; }
        else { it -= TR_IDN; j.W = FIN(15); j.ldw = 3072; nblk = 48; j.WT = (bf16_t*)(ws + WS_W_IN1); j.ldt = 2048; }
    } else if (list == 3) { j.W = FIN(21) + (size_t)DM * FF2; j.ldw = FF2; nblk = 176; j.WT = (bf16_t*)(ws + WS_W_UP1); j.ldt = 2048; }
    else { j.W = FIN(24) + (size_t)FF * DM; j.ldw = 2048; nblk = 32; j.WT = (bf16_t*)(ws + WS_W_DN1); j.ldt = FF; }
    j.k0 = 64 * (it / nblk); j.n0 = 64 * (it % nblk);
    return j;
}
__device__ __forceinline__ int tr_count(int list) {
    return list == 0 ? TR_I0 + 4 * TR_I1 : list == 1 ? TR_IUP : list == 2 ? TR_IDN + TR_IIN1 : list == 3 ? TR_IUP : TR_IDN;
}
__device__ __forceinline__ void tr_load(const TJ& j, f32x4 (&v)[16], int lane) {
    const int kl = lane >> 4, nl = (lane & 15) * 4;
#pragma unroll
    for (int i = 0; i < 16; ++i) v[i] = __builtin_nontemporal_load((const f32x4*)(j.W + (size_t)(j.k0 + i * 4 + kl) * j.ldw + j.n0 + nl));
}
__device__ __forceinline__ void tr_store(const TJ& j, const f32x4 (&v)[16], LAS float* scr, int lane) {
    const int kl = lane >> 4, nl = (lane & 15) * 4;
#pragma unroll
    for (int i = 0; i < 16; ++i) { LAS float* d = scr + (i * 4 + kl) * 65 + nl; d[0] = v[i][0]; d[1] = v[i][1]; d[2] = v[i][2]; d[3] = v[i][3]; }
    asm volatile("s_waitcnt lgkmcnt(0)" ::: "memory");
    const int c = lane & 7;
#pragma unroll
    for (int q = 0; q < 8; ++q) { const int n = (lane >> 3) + 8 * q; const LAS float* sp = scr + (8 * c) * 65 + n;
        u32x4 o; o.x = cvt_pk_bf16(sp[0 * 65], sp[1 * 65]); o.y = cvt_pk_bf16(sp[2 * 65], sp[3 * 65]); o.z = cvt_pk_bf16(sp[4 * 65], sp[5 * 65]); o.w = cvt_pk_bf16(sp[6 * 65], sp[7 * 65]);
        *(u32x4*)(j.WT + (size_t)(j.n0 + n) * j.ldt + j.k0 + 8 * c) = o; }
    asm volatile("s_waitcnt lgkmcnt(0)" ::: "memory");
}
__device__ __forceinline__ void tr_run(const Ctx& F, LAS unsigned char* lds, int list, int first, int stride) {
    LAS float* scr = (LAS float*)(lds + F.wave * TR_SCR);
    const int total = tr_count(list);
    int it = first; if (it >= total) return;
    TJ j = tr_decode(F, list, it); f32x4 v[16]; tr_load(j, v, F.lane);
    for (;;) {
        const int itn = it + stride; const bool more = itn < total;
        TJ jn = j; f32x4 vn[16];
        if (more) { jn = tr_decode(F, list, itn); tr_load(jn, vn, F.lane); }
        tr_store(j, v, scr, F.lane);
        if (!more) break;
        j = jn; it = itn;
#pragma unroll
        for (int i = 0; i < 16; ++i) v[i] = vn[i];
    }
}

__device__ __forceinline__ void filler_items(const Ctx& F, LAS unsigned char* lds, int ph, int first_idle) {
    tr_run(F, lds, ph == PH_G_IN0 ? 1 : (ph == PH_G_UP0 ? 2 : (ph == PH_G_IN1 ? 3 : 4)), (F.bid - first_idle) * 8 + F.wave, (F.G - first_idle) * 8);
    __syncthreads();
}

__device__ __forceinline__ void phase_prep(const Ctx& F, LAS unsigned char* lds) {
    unsigned char* ws = F.ws;
    const int gw = F.bid * 8 + F.wave, NGW = F.G * 8;
    tr_run(F, lds, 0, gw, NGW);
    {
        const int gt = F.bid * 512 + F.tid, NGT = F.G * 512;
        bf16_t* wfo = (bf16_t*)(ws + WS_W_FO);
        for (int i = gt; i < 1024 * 1024 / 4; i += NGT) { const f32x4 v = *(const f32x4*)(FIN(19) + (size_t)i * 4); u32x2 o; o.x = cvt_pk_bf16(v[0], v[1]); o.y = cvt_pk_bf16(v[2], v[3]); *(u32x2*)(wfo + (size_t)i * 4) = o; }
        bf16_t* wpl = (bf16_t*)(ws + WS_W_POOL);
        for (int i = gt; i < 4 * 65536 / 4; i += NGT) { const int e0 = i * 4, g = e0 >> 16, co = e0 & 255; const f32x4 v = *(const f32x4*)(FIN(12) + e0); const f32x4 s = *(const f32x4*)(FIN(13) + g * 256 + co);
            u32x2 o; o.x = cvt_pk_bf16(v[0] * s[0], v[1] * s[1]); o.y = cvt_pk_bf16(v[2] * s[2], v[3] * s[3]); *(u32x2*)(wpl + e0) = o; }
        bf16_t* wsp = (bf16_t*)(ws + WS_W_SPBD);
        for (int i = gt; i < 4 * 65536; i += NGT) { const int g = i >> 16, p = (i >> 8) & 255, q = i & 255;
            const float v = ((p >> 7) == (q >> 7)) ? FIN(17)[g * 16384 + (p & 127) * 128 + (q & 127)] : 0.f; wsp[i] = f2bf(v); }
        bf16_t* a1 = (bf16_t*)(ws + WS_W_A1);
        for (int i = gt; i < 256 * 256; i += NGT) { const int r = i >> 8, k = i & 255, pp = r >> 7, d = r & 127, p = k >> 7, b = k & 127; const float x = (float)((b * d) & 127) * (1.0f / 64.0f);
            const float v = (pp == p ? cospif(x) : (pp == 0 ? sinpif(x) : -sinpif(x))) * 0.08838834764831845f; a1[i] = f2bf(v); }
        bf16_t* a2 = (bf16_t*)(ws + WS_W_A2);
        for (int i = gt; i < 256 * 512; i += NGT) { const int r = i >> 9, k = i & 511, dj = r >> 6, c = r & 63, dk = k >> 7, pp = (k >> 6) & 1, a = k & 63; const float x = (float)((a * c) & 63) * (1.0f / 32.0f);
            const float v = dj == dk ? (pp ? sinpif(x) : cospif(x)) * 0.125f : 0.f; a2[i] = f2bf(v); }
        float* tw = (float*)(ws + WS_TW);
        for (int i = gt; i < 8192; i += NGT) { const int d = i >> 6, a = i & 63; const float x = (float)(a * d) * (1.0f / 4096.0f); tw[i] = cospif(x); tw[8192 + i] = sinpif(x); }
        bf16_t* chd = (bf16_t*)(ws + WS_W_CHD);
        for (int i = gt; i < 256 * 128; i += NGT) { const int n = i >> 7, j = i & 127, part = n >> 7, m = n & 127; const float x = (float)((m * j) & 127) * (1.0f / 64.0f);
            const float v = (part == 0 ? cospif(x) : -sinpif(x)) * 0.08838834764831845f; chd[i] = f2bf(v); }
    }
    {
        const int gt = F.bid * 512 + F.tid, NGT = F.G * 512;
        for (int i = gt; i < TAB_UNITS; i += NGT) {
            int ph = PH_G_DN1;
            if (i < 386) ph = PH_G_IN0; else if (i < 642) ph = PH_G_OUT0; else if (i < 2094) ph = PH_G_UP0; else if (i < 2350) ph = PH_G_DN0; else if (i < 2734) ph = PH_G_IN1;
            else if (i < 2990) ph = PH_G_F1; else if (i < 3246) ph = PH_G_S1; else if (i < 3502) ph = PH_G_S2; else if (i < 3758) ph = PH_G_OUT1; else if (i < 5210) ph = PH_G_UP1;
            GU u; EP e; unit_desc(F, ph, i - tab_off(ph), u, e);
            store_rec((unsigned long long*)(ws + WS_TAB) + (size_t)i * 16, u, e);
        }
    }
}

__device__ __forceinline__ void phase_gemv(const Ctx& F, LAS unsigned char* lds) {
    float* mod = (float*)(F.ws + WS_CTL); float* modc = mod + 2 * 12288;
    LAS f32x2* red = (LAS f32x2*)lds;
    LAS float* sl = (LAS float*)(lds + 16384);
    if (F.bid < 192) {
        for (int i = F.tid; i < 4096; i += 512) { const float v = i < 2048 ? FIN(1)[i] : FIN(3)[i - 2048]; sl[i] = v / (1.f + __expf(-v)); }
        __syncthreads();
    }
    for (int it = F.bid; it < 192; it += F.G) {
        const int l = it / 96, cb = it % 96; const bool dc = (l == 0) && (cb * 128 < 4096);
        const int n0 = cb * 128 + F.lane * 2, k0 = F.wave * 256;
        const float* wp = FIN(4) + ((size_t)l * DM + k0) * 12288 + n0;
        f32x2 a = {0.f, 0.f}, ac = {0.f, 0.f};
        for (int kb = 0; kb < 256; kb += 32) {
            f32x2 w[32];
#pragma unroll
            for (int k = 0; k < 32; ++k) w[k] = __builtin_nontemporal_load((const f32x2*)(wp + (size_t)(kb + k) * 12288));
#pragma unroll
            for (int k = 0; k < 32; ++k) { a += w[k] * sl[k0 + kb + k]; if (dc) ac += w[k] * sl[2048 + k0 + kb + k]; }
        }
        __syncthreads();
        red[(F.wave * 64 + F.lane) * 2] = a; red[(F.wave * 64 + F.lane) * 2 + 1] = ac;
        __syncthreads();
        if (F.tid < 64) {
            f32x2 sa = *(const f32x2*)(FIN(5) + l * 12288 + n0), sc = sa;
#pragma unroll
            for (int w8 = 0; w8 < 8; ++w8) { sa += red[(w8 * 64 + F.lane) * 2]; sc += red[(w8 * 64 + F.lane) * 2 + 1]; }
            *(f32x2*)(mod + l * 12288 + n0) = sa;
            if (dc) *(f32x2*)(modc + n0) = sc;
        }
    }
    __syncthreads();
}

__device__ __forceinline__ void norm_rows(const Ctx& F, const float* X, const float* Xc, int nrows, const float* g, const float* shift, const float* scale, const float* shiftc, const float* scalec, bf16_t* Hout) {
    const int gw = F.bid * 8 + F.wave, NGW = F.G * 8;
    for (int row0 = gw; row0 < nrows; row0 += 2 * NGW) {
        f32x4 v[2][8]; float ss[2];
#pragma unroll
        for (int h = 0; h < 2; ++h) {
            const int row = row0 + h * NGW;
            if (row < nrows) {
                const bool isc = row >= NT;
                const f32x4* xr = (const f32x4*)(isc ? Xc + (size_t)(row - NT) * DM : X + (size_t)row * DM) + F.lane;
#pragma unroll
                for (int j = 0; j < 8; ++j) v[h][j] = xr[64 * j];
            } else {
#pragma unroll
                for (int j = 0; j < 8; ++j) v[h][j] = (f32x4){0.f, 0.f, 0.f, 0.f};
            }
        }
#pragma unroll
        for (int h = 0; h < 2; ++h) { float s = 0.f;
#pragma unroll
            for (int j = 0; j < 8; ++j) s += (v[h][j][0] * v[h][j][0] + v[h][j][1] * v[h][j][1]) + (v[h][j][2] * v[h][j][2] + v[h][j][3] * v[h][j][3]);
            ss[h] = wave_sum(s); }
#pragma unroll
        for (int h = 0; h < 2; ++h) {
            const int row = row0 + h * NGW;
            if (row < nrows) {
                const bool isc = row >= NT;
                const float* shp = isc ? shiftc : shift; const float* scp = isc ? scalec : scale;
                const float rstd = 1.0f / sqrtf(ss[h] * (1.0f / DM) + EPS);
#pragma unroll
                for (int j = 0; j < 8; ++j) {
                    const int col = 4 * F.lane + 256 * j;
                    const f32x4 g4 = *(const f32x4*)(g + col), sh = *(const f32x4*)(shp + col), sc = *(const f32x4*)(scp + col);
                    const f32x4 o = (v[h][j] * rstd) * g4 * (sc + 1.0f) + sh;
                    u32x2 w; w.x = cvt_pk_bf16(o[0], o[1]); w.y = cvt_pk_bf16(o[2], o[3]);
                    *(u32x2*)(Hout + (size_t)row * DM + col) = w;
                }
            }
        }
    }
}

template <int HW> __device__ __forceinline__ void pool_item(const bf16_t* ZB, bf16_t* CAT, int t0, int c0) {
    constexpr int NR = 8 + 2 * HW;
    u32x4 rows[NR];
#pragma unroll
    for (int r = 0; r < NR; ++r) { const int tok = t0 - HW + r; rows[r] = (tok >= 0 && tok < NT) ? *(const u32x4*)(ZB + (size_t)tok * 1024 + c0) : (u32x4){0u, 0u, 0u, 0u}; }
    float s[8] = {0.f, 0.f, 0.f, 0.f, 0.f, 0.f, 0.f, 0.f};
#pragma unroll
    for (int r = 0; r < 2 * HW; ++r) { const u32x4 z = rows[r];
        s[0] += bflo(z.x); s[1] += bfhi(z.x); s[2] += bflo(z.y); s[3] += bfhi(z.y); s[4] += bflo(z.z); s[5] += bfhi(z.z); s[6] += bflo(z.w); s[7] += bfhi(z.w); }
#pragma unroll
    for (int j = 0; j < 8; ++j) {
        const int t = t0 + j; const int lo = t - HW < 0 ? 0 : t - HW, hi = t + HW > NT ? NT : t + HW;
        const float rc = 1.0f / (float)(hi - lo);
        const u32x4 z = rows[HW + j];
        u32x4 o; o.x = cvt_pk_bf16(s[0] * rc - bflo(z.x), s[1] * rc - bfhi(z.x)); o.y = cvt_pk_bf16(s[2] * rc - bflo(z.y), s[3] * rc - bfhi(z.y));
        o.z = cvt_pk_bf16(s[4] * rc - bflo(z.z), s[5] * rc - bfhi(z.z)); o.w = cvt_pk_bf16(s[6] * rc - bflo(z.w), s[7] * rc - bfhi(z.w));
        *(u32x4*)(CAT + (size_t)t * 2048 + 1024 + c0) = o;
        if (j < 7) { const u32x4 zo = rows[j], zn = rows[j + 2 * HW];
            s[0] += bflo(zn.x) - bflo(zo.x); s[1] += bfhi(zn.x) - bfhi(zo.x); s[2] += bflo(zn.y) - bflo(zo.y); s[3] += bfhi(zn.y) - bfhi(zo.y);
            s[4] += bflo(zn.z) - bflo(zo.z); s[5] += bfhi(zn.z) - bfhi(zo.z); s[6] += bflo(zn.w) - bflo(zo.w); s[7] += bfhi(zn.w) - bfhi(zo.w); }
    }
}
__device__ __forceinline__ float row16_sum(float v) {
    v += __shfl_xor(v, 1); v += __shfl_xor(v, 2); v += __shfl_xor(v, 4); v += __shfl_xor(v, 8); return v;
}
__device__ __forceinline__ void phase_qkpool(const Ctx& F) {
    unsigned char* ws = F.ws;
    const int gw = F.bid * 8 + F.wave, NGW = F.G * 8;
    bf16_t* QB = (bf16_t*)(ws + WS_QB); bf16_t* KB = (bf16_t*)(ws + WS_KB);
    const int hs = F.lane >> 4, li = F.lane & 15, half = li >> 3, i0 = 4 * (li & 7), e1 = half * 64 + i0;
    float inv[4], gq1[4], gq2[4], gk1[4], gk2[4];
#pragma unroll
    for (int j = 0; j < 4; ++j) { inv[j] = exp2f(-(float)(i0 + j) * (13.287712379549449f / 32.0f)); gq1[j] = FIN(9)[e1 + j]; gq2[j] = FIN(9)[e1 + 32 + j]; gk1[j] = FIN(10)[e1 + j]; gk2[j] = FIN(10)[e1 + 32 + j]; }
    for (int row = gw; row < MR; row += NGW) {
        const bool isctx = row >= NT;
        float cs[4], sn[4];
        const float pos = isctx ? 0.f : (float)(half == 0 ? (row >> 6) : (row & 63));
#pragma unroll
        for (int j = 0; j < 4; ++j) { const float a = pos * inv[j]; sn[j] = __sinf(a); cs[j] = __cosf(a); }
        bf16_t* ptr[3]; bool act[3]; u32x2 v1[3], v2[3];
#pragma unroll
        for (int ps = 0; ps < 3; ++ps) { const int h = ps * 4 + hs; act[ps] = h < 8 ? !isctx : (h < 10);
            ptr[ps] = h < 8 ? QB + (size_t)(isctx ? 0 : row) * 1024 + h * 128 + e1 : KB + (size_t)row * 256 + ((h - 8) & 1) * 128 + e1;
            if (act[ps]) { v1[ps] = *(const u32x2*)ptr[ps]; v2[ps] = *(const u32x2*)(ptr[ps] + 32); } else { v1[ps] = (u32x2){0u, 0u}; v2[ps] = (u32x2){0u, 0u}; } }
#pragma unroll
        for (int ps = 0; ps < 3; ++ps) {
            const bool isq = (ps * 4 + hs) < 8;
            float x1[4] = {bflo(v1[ps].x), bfhi(v1[ps].x), bflo(v1[ps].y), bfhi(v1[ps].y)}, x2[4] = {bflo(v2[ps].x), bfhi(v2[ps].x), bflo(v2[ps].y), bfhi(v2[ps].y)};
            float ss = 0.f;
#pragma unroll
            for (int j = 0; j < 4; ++j) ss += x1[j] * x1[j] + x2[j] * x2[j];
            ss = row16_sum(ss);
            const float r = 1.0f / sqrtf(ss * (1.0f / 128.0f) + EPS);
            float o1[4], o2[4];
#pragma unroll
            for (int j = 0; j < 4; ++j) { const float y1 = x1[j] * r * (isq ? gq1[j] : gk1[j]), y2 = x2[j] * r * (isq ? gq2[j] : gk2[j]); o1[j] = y1 * cs[j] - y2 * sn[j]; o2[j] = y2 * cs[j] + y1 * sn[j]; }
            if (act[ps]) { u32x2 w1, w2; w1.x = cvt_pk_bf16(o1[0], o1[1]); w1.y = cvt_pk_bf16(o1[2], o1[3]); w2.x = cvt_pk_bf16(o2[0], o2[1]); w2.y = cvt_pk_bf16(o2[2], o2[3]);
                *(u32x2*)ptr[ps] = w1; *(u32x2*)(ptr[ps] + 32) = w2; }
        }
    }
    const bf16_t* ZB = (const bf16_t*)(ws + WS_ZB); bf16_t* CAT = (bf16_t*)(ws + WS_CAT);
    const int gt = F.bid * 512 + F.tid, NGT = F.G * 512;
    for (int id = gt; id < (NT / 8) * 128; id += NGT) {
        const int t0 = (id >> 7) * 8, c0 = (id & 127) * 8, g = c0 >> 8;
        if (g == 0) pool_item<1>(ZB, CAT, t0, c0); else if (g == 1) pool_item<2>(ZB, CAT, t0, c0); else if (g == 2) pool_item<4>(ZB, CAT, t0, c0); else pool_item<8>(ZB, CAT, t0, c0);
    }
}

__device__ __forceinline__ void phase_attn(const Ctx& F, LAS unsigned char* lds) {
    unsigned char* ws = F.ws;
    const bf16_t* QB = (const bf16_t*)(ws + WS_QB); const bf16_t* KB = (const bf16_t*)(ws + WS_KB); const bf16_t* VT = (const bf16_t*)(ws + WS_VT);
    bf16_t* CAT = (bf16_t*)(ws + WS_CAT);
    LAS bf16_t* Ks = (LAS bf16_t*)lds;
    LAS bf16_t* Vs = (LAS bf16_t*)(lds + 64 * 272);
    const int lane = F.lane, w = F.wave, fr = lane & 15, fq = lane >> 4, tid = F.tid;
    const float cexp = 0.08838834764831845f * 1.4426950408889634f;
    for (int L = F.bid; L < 512; L += F.G) {
        const int qb = L >> 3, hq = L & 7, hk = hq >> 2;
        const int qrow = qb * 128 + w * 16 + fr;
        bf16x8 qf[4];
#pragma unroll
        for (int ks = 0; ks < 4; ++ks) qf[ks] = *(const bf16x8*)(QB + (size_t)qrow * 1024 + hq * 128 + ks * 32 + fq * 8);
        f32x4 o[8];
#pragma unroll
        for (int d = 0; d < 8; ++d) o[d] = (f32x4){0.f, 0.f, 0.f, 0.f};
        float mrun = -1e30f, lrun = 0.f;
        u32x4 kreg[2], vreg[2];
        int ti = 0;
#define ATT_TILE(ti_, ks_, mk_) do { if ((ti_) < 2) { ks_ = qb * 128 + (ti_) * 64; mk_ = 0; } else if ((ti_) < 4) { ks_ = (qb - 1) * 128 + ((ti_) - 2) * 64; mk_ = 1; } \
            else if ((ti_) < 6) { ks_ = (qb + 1) * 128 + ((ti_) - 4) * 64; mk_ = 2; } else { ks_ = NT + ((ti_) - 6) * 64; mk_ = 0; } } while (0)
#define ATT_SKIP(ti_) (((ti_) >= 2 && (ti_) < 4 && qb == 0) || ((ti_) >= 4 && (ti_) < 6 && qb == 63))
#define ATT_LOAD(ks_) do { _Pragma("unroll") for (int it = 0; it < 2; ++it) { const int id = tid + 512 * it; \
                kreg[it] = *(const u32x4*)(KB + (size_t)((ks_) + (id >> 4)) * 256 + hk * 128 + (id & 15) * 8); \
                vreg[it] = *(const u32x4*)(VT + (size_t)(hk * 128 + (id >> 3)) * MR + (ks_) + (id & 7) * 8); } } while (0)
        { int ks0, mk0; ATT_TILE(0, ks0, mk0); (void)mk0; ATT_LOAD(ks0); }
        for (; ti < 10; ) {
            int kstart, mk; ATT_TILE(ti, kstart, mk);
            int tn = ti + 1; while (tn < 10 && ATT_SKIP(tn)) ++tn;
            __syncthreads();
#pragma unroll
            for (int it = 0; it < 2; ++it) { const int id = tid + 512 * it;
                *(LAS u32x4*)(Ks + (id >> 4) * 136 + (id & 15) * 8) = kreg[it];
                *(LAS u32x4*)(Vs + (id >> 3) * 72 + (id & 7) * 8) = vreg[it]; }
            if (tn < 10) { int ksn, mkn; ATT_TILE(tn, ksn, mkn); (void)mkn; ATT_LOAD(ksn); }
            ti = tn;
            __syncthreads();
            f32x4 s[4];
#pragma unroll
            for (int sub = 0; sub < 4; ++sub) {
                s[sub] = (f32x4){0.f, 0.f, 0.f, 0.f};
#pragma unroll
                for (int ks = 0; ks < 4; ++ks) {
                    const bf16x8 kf = *(const LAS bf16x8*)(Ks + (sub * 16 + fr) * 136 + ks * 32 + fq * 8);
                    s[sub] = __builtin_amdgcn_mfma_f32_16x16x32_bf16(kf, qf[ks], s[sub], 0, 0, 0);
                }
            }
            if (mk) {
#pragma unroll
                for (int sub = 0; sub < 4; ++sub)
#pragma unroll
                    for (int j = 0; j < 4; ++j) { const int kpos = kstart + sub * 16 + fq * 4 + j; const int df = mk == 1 ? qrow - kpos : kpos - qrow; if (df > 128) s[sub][j] = -1e30f; }
            }
            float tm = -1e30f;
#pragma unroll
            for (int sub = 0; sub < 4; ++sub)
#pragma unroll
                for (int j = 0; j < 4; ++j) tm = fmaxf(tm, s[sub][j]);
            tm = fmaxf(tm, __shfl_xor(tm, 16)); tm = fmaxf(tm, __shfl_xor(tm, 32));
            const float mnew = fmaxf(mrun, tm);
            const float alpha = exp2f((mrun - mnew) * cexp);
            mrun = mnew;
            float ps = 0.f;
#pragma unroll
            for (int sub = 0; sub < 4; ++sub)
#pragma unroll
                for (int j = 0; j < 4; ++j) { const float p = exp2f((s[sub][j] - mnew) * cexp); s[sub][j] = p; ps += p; }
            lrun = lrun * alpha + ps;
#pragma unroll
            for (int d = 0; d < 8; ++d) o[d] = o[d] * alpha;
#pragma unroll
            for (int kk = 0; kk < 2; ++kk) {
                u32x4 pw; pw.x = cvt_pk_bf16(s[2 * kk][0], s[2 * kk][1]); pw.y = cvt_pk_bf16(s[2 * kk][2], s[2 * kk][3]);
                pw.z = cvt_pk_bf16(s[2 * kk + 1][0], s[2 * kk + 1][1]); pw.w = cvt_pk_bf16(s[2 * kk + 1][2], s[2 * kk + 1][3]);
                const bf16x8 pf = __builtin_bit_cast(bf16x8, pw);
#pragma unroll
                for (int d = 0; d < 8; ++d) {
                    const LAS bf16_t* vp = Vs + (d * 16 + fr) * 72 + kk * 32 + fq * 4;
                    const u32x2 lo = *(const LAS u32x2*)vp, hi = *(const LAS u32x2*)(vp + 16);
                    u32x4 vw; vw.x = lo.x; vw.y = lo.y; vw.z = hi.x; vw.w = hi.y;
                    o[d] = __builtin_amdgcn_mfma_f32_16x16x32_bf16(__builtin_bit_cast(bf16x8, vw), pf, o[d], 0, 0, 0);
                }
            }
        }
#undef ATT_TILE
#undef ATT_SKIP
#undef ATT_LOAD
        lrun += __shfl_xor(lrun, 16); lrun += __shfl_xor(lrun, 32);
        lrun += exp2f(FIN(11)[hq] * 1.4426950408889634f - mrun * cexp);
        const float rl = 1.0f / lrun;
#pragma unroll
        for (int d = 0; d < 8; ++d) {
            u32x2 wv; wv.x = cvt_pk_bf16(o[d][0] * rl, o[d][1] * rl); wv.y = cvt_pk_bf16(o[d][2] * rl, o[d][3] * rl);
            *(u32x2*)(CAT + (size_t)qrow * 2048 + hq * 128 + d * 16 + fq * 4) = wv;
        }
    }
    __syncthreads();
}

__device__ __forceinline__ void phase_conv(const Ctx& F, int layer) {
    unsigned char* ws = F.ws;
    const bf16_t* U = (const bf16_t*)(ws + WS_U); bf16_t* ACT = (bf16_t*)(ws + WS_ACT);
    const float* cw = FIN(22) + (size_t)layer * 3 * FF2; const float* cb = FIN(23) + (size_t)layer * FF2;
    const int gw = F.bid * 8 + F.wave, NGW = F.G * 8;
    for (int it = gw; it < 256 * 11; it += NGW) {
        const int tc = it / 11, cbk = it % 11; const int c0 = cbk * 512 + F.lane * 8, t0 = tc * 32;
        float wg[3][8], wv[3][8], bg[8], bv[8];
#pragma unroll
        for (int r = 0; r < 3; ++r)
#pragma unroll
            for (int j = 0; j < 8; j += 4) { const f32x4 a = *(const f32x4*)(cw + (size_t)r * FF2 + c0 + j), b = *(const f32x4*)(cw + (size_t)r * FF2 + FF + c0 + j);
                wg[r][j] = a[0]; wg[r][j + 1] = a[1]; wg[r][j + 2] = a[2]; wg[r][j + 3] = a[3]; wv[r][j] = b[0]; wv[r][j + 1] = b[1]; wv[r][j + 2] = b[2]; wv[r][j + 3] = b[3]; }
#pragma unroll
        for (int j = 0; j < 8; j += 4) { const f32x4 a = *(const f32x4*)(cb + c0 + j), b = *(const f32x4*)(cb + FF + c0 + j);
            bg[j] = a[0]; bg[j + 1] = a[1]; bg[j + 2] = a[2]; bg[j + 3] = a[3]; bv[j] = b[0]; bv[j + 1] = b[1]; bv[j + 2] = b[2]; bv[j + 3] = b[3]; }
        const u32x4 zero = {0u, 0u, 0u, 0u};
        u32x4 pg, pv, cg_, cv;
        if (t0 > 0) { pg = *(const u32x4*)(U + (size_t)(t0 - 1) * FF2 + c0); pv = *(const u32x4*)(U + (size_t)(t0 - 1) * FF2 + FF + c0); } else { pg = zero; pv = zero; }
        cg_ = *(const u32x4*)(U + (size_t)t0 * FF2 + c0); cv = *(const u32x4*)(U + (size_t)t0 * FF2 + FF + c0);
        for (int tb = t0; tb < t0 + 32; tb += 8) {
            u32x4 rg[8], rv[8];
#pragma unroll
            for (int q = 0; q < 8; ++q) { const int tt = tb + 1 + q;
                if (tt < NT) { rg[q] = *(const u32x4*)(U + (size_t)tt * FF2 + c0); rv[q] = *(const u32x4*)(U + (size_t)tt * FF2 + FF + c0); } else { rg[q] = zero; rv[q] = zero; } }
#pragma unroll
            for (int q8 = 0; q8 < 8; ++q8) {
                const int t = tb + q8; const u32x4 ng = rg[q8], nv = rv[q8];
                float og[8], ov[8];
#pragma unroll
                for (int q = 0; q < 4; ++q) {
                    og[2 * q] = wg[0][2 * q] * bflo(pg[q]) + wg[1][2 * q] * bflo(cg_[q]) + wg[2][2 * q] * bflo(ng[q]) + bg[2 * q];
                    og[2 * q + 1] = wg[0][2 * q + 1] * bfhi(pg[q]) + wg[1][2 * q + 1] * bfhi(cg_[q]) + wg[2][2 * q + 1] * bfhi(ng[q]) + bg[2 * q + 1];
                    ov[2 * q] = wv[0][2 * q] * bflo(pv[q]) + wv[1][2 * q] * bflo(cv[q]) + wv[2][2 * q] * bflo(nv[q]) + bv[2 * q];
                    ov[2 * q + 1] = wv[0][2 * q + 1] * bfhi(pv[q]) + wv[1][2 * q + 1] * bfhi(cv[q]) + wv[2][2 * q + 1] * bfhi(nv[q]) + bv[2 * q + 1];
                }
                float r[8];
#pragma unroll
                for (int j = 0; j < 8; ++j) r[j] = og[j] / (1.f + __expf(-og[j])) * ov[j];
                u32x4 o; o.x = cvt_pk_bf16(r[0], r[1]); o.y = cvt_pk_bf16(r[2], r[3]); o.z = cvt_pk_bf16(r[4], r[5]); o.w = cvt_pk_bf16(r[6], r[7]);
                *(u32x4*)(ACT + (size_t)t * FF + c0) = o;
                pg = cg_; pv = cv; cg_ = ng; cv = nv;
            }
        }
    }
}

__device__ __forceinline__ void phase_vtn(const Ctx& F, LAS unsigned char* lds) {
    unsigned char* ws = F.ws;
    const bf16_t* GV = (const bf16_t*)(ws + WS_GV); bf16_t* VTN = (bf16_t*)(ws + WS_VTN);
    LAS bf16_t* tile = (LAS bf16_t*)lds;
    LAS float* rs = (LAS float*)(lds + 32 * 1032 * 2);
    const float* gn = FIN(16);
    for (int it = F.bid; it < 256; it += F.G) {
        const int t0 = it * 32;
        __syncthreads();
#pragma unroll
        for (int i = 0; i < 8; ++i) { const int id = F.tid + 512 * i, r = id >> 7, c = (id & 127) * 8; *(LAS u32x4*)(tile + r * 1032 + c) = *(const u32x4*)(GV + (size_t)(t0 + r) * 1024 + c); }
        __syncthreads();
#pragma unroll
        for (int i = 0; i < 4; ++i) { const int r = F.wave * 4 + i; float s = 0.f;
#pragma unroll
            for (int j = 0; j < 2; ++j) { const u32x4 z = *(const LAS u32x4*)(tile + r * 1032 + (F.lane + 64 * j) * 8);
                s += bflo(z.x) * bflo(z.x) + bfhi(z.x) * bfhi(z.x) + bflo(z.y) * bflo(z.y) + bfhi(z.y) * bfhi(z.y) + bflo(z.z) * bflo(z.z) + bfhi(z.z) * bfhi(z.z) + bflo(z.w) * bflo(z.w) + bfhi(z.w) * bfhi(z.w); }
            s = wave_sum(s); if (F.lane == 0) rs[r] = 1.0f / sqrtf(s * (1.0f / 1024.0f) + EPS); }
        __syncthreads();
#pragma unroll
        for (int i = 0; i < 8; ++i) { const int id = F.tid + 512 * i, c = id >> 2, tq = id & 3; const float gc = gn[c];
            float v[8];
#pragma unroll
            for (int j = 0; j < 8; ++j) v[j] = bf2f(tile[(tq * 8 + j) * 1032 + c]) * rs[tq * 8 + j] * gc;
            u32x4 o; o.x = cvt_pk_bf16(v[0], v[1]); o.y = cvt_pk_bf16(v[2], v[3]); o.z = cvt_pk_bf16(v[4], v[5]); o.w = cvt_pk_bf16(v[6], v[7]);
            *(u32x4*)(VTN + (size_t)c * 8192 + t0 + tq * 8) = o; }
    }
    __syncthreads();
}


#define XB_TMO      128
#define XB_XCNT(j)  (256  + 64 * (j))
#define XB_XSUB(j)  (1280 + 64 * (j))
#define XB_XGEN(j)  (2304 + 64 * (j))
#define XB_TOP      3328
#define XB_TOPGEN   3392
#define XCD_BAR_WORDS 3456
#define XB_SPIN_CAP (1u << 18)
__device__ __forceinline__ unsigned xb_ld(unsigned* p)              { return __hip_atomic_load(p, __ATOMIC_RELAXED, __HIP_MEMORY_SCOPE_AGENT); }
__device__ __forceinline__ unsigned xb_add(unsigned* p, unsigned v) { return __hip_atomic_fetch_add(p, v, __ATOMIC_RELAXED, __HIP_MEMORY_SCOPE_AGENT); }
__device__ __forceinline__ unsigned xb_xcc_id() { return (unsigned)__builtin_amdgcn_s_getreg((3 << 11) | 20) & 0xFu; }
#define XB_SPIN(cond, bar) do { unsigned _sp = 0; while (cond) { __builtin_amdgcn_s_sleep(1); \
    if ((++_sp & 255u) == 0u) { if (xb_ld(&(bar)[XB_TMO])) break; if (_sp > XB_SPIN_CAP) { atomicAdd(&(bar)[XB_TMO], 1u); break; } } } } while (0)
struct XcdBarrier { unsigned* bar; unsigned x; volatile LAS unsigned* st; };
__device__ __forceinline__ XcdBarrier xcd_barrier_post(unsigned* bar, volatile LAS unsigned* st) {
    XcdBarrier b; b.bar = bar; b.x = xb_xcc_id(); b.st = st;
    if (threadIdx.x == 0) (void)xb_add(&bar[XB_XCNT(b.x)], 1u);
    return b;
}
__device__ __forceinline__ void xcd_barrier_complete(unsigned* bar, unsigned x, unsigned& nloc, unsigned& nx) {
    const unsigned G = gridDim.x * gridDim.y * gridDim.z;
    unsigned sum, cnt, mine, sp = 0u;
    for (;;) {
        sum = 0u; cnt = 0u; mine = 0u;
#pragma unroll
        for (unsigned j = 0; j < 16; ++j) { const unsigned c = xb_ld(&bar[XB_XCNT(j)]); sum += c; cnt += (c > 0u) ? 1u : 0u; mine = (j == x) ? c : mine; }
        if (sum == G) break;
        __builtin_amdgcn_s_sleep(1);
        if ((++sp & 255u) == 0u) { if (xb_ld(&bar[XB_TMO])) break; if (sp > XB_SPIN_CAP) { atomicAdd(&bar[XB_TMO], 1u); break; } }
    }
    nloc = mine > 0u ? mine : 1u; nx = cnt > 0u ? cnt : 1u;
}
__device__ __forceinline__ void xcd_barrier(const XcdBarrier& b) {
    asm volatile("s_waitcnt vmcnt(0)" ::: "memory");
    __syncthreads();
    if (threadIdx.x == 0) {
        unsigned* bar = b.bar;
        __builtin_amdgcn_s_waitcnt(0);
        unsigned nloc = b.st[0], nx = b.st[1];
        if (nloc == 0u) { xcd_barrier_complete(bar, b.x, nloc, nx); b.st[0] = nloc; b.st[1] = nx; }
        const unsigned old = xb_add(&bar[XB_XSUB(b.x)], 1u);
        const unsigned gen = old / nloc;
        if (old + 1u == (gen + 1u) * nloc) {
            __builtin_amdgcn_fence(__ATOMIC_RELEASE, "agent");
            asm volatile("s_waitcnt vmcnt(0)" ::: "memory");
            const unsigned og = xb_add(&bar[XB_TOP], 1u);
            const unsigned tg = og / nx;
            if (og + 1u == (tg + 1u) * nx) xb_add(&bar[XB_TOPGEN], 1u);
            else XB_SPIN(xb_ld(&bar[XB_TOPGEN]) == tg, bar);
            __builtin_amdgcn_fence(__ATOMIC_ACQUIRE, "agent");
            xb_add(&bar[XB_XGEN(b.x)], 1u);
            asm volatile("s_waitcnt vmcnt(0)" ::: "memory");
        } else {
            XB_SPIN(xb_ld(&bar[XB_XGEN(b.x)]) == gen, bar);
            __builtin_amdgcn_fence(__ATOMIC_ACQUIRE, "agent");
            asm volatile("s_waitcnt vmcnt(0)" ::: "memory");
        }
    }
    __syncthreads();
}
constexpr size_t WS_BAR = 512 * 1024;

constexpr int MISC_OFF = 8 * TR_SCR + 1024, LDS_BYTES = HALO_OFF + 8192;
static_assert(MISC_OFF >= STAGE_BYTES && HALO_OFF == MISC_OFF + 1024 && LDS_BYTES <= 160 * 1024, "LDS map");
__global__ void __launch_bounds__(512, 2) fwd_mega(Args args) {
    extern __shared__ __attribute__((aligned(16))) unsigned char lds_raw[];
    LAS unsigned char* lds = (LAS unsigned char*)lds_raw;
    cg::grid_group grid = cg::this_grid();
    Ctx F;
    F.ap = nullptr; F.out = nullptr; F.ws = nullptr; F.rep = 0;
    F.tid = threadIdx.x; F.lane = F.tid & 63; F.wave = __builtin_amdgcn_readfirstlane(F.tid >> 6); F.G = gridDim.x; F.bid = blockIdx.x;
    const int lo = args.ph_lo, hi = args.ph_hi;
    if (lo < 0) grid.sync();
    volatile LAS unsigned* misc = (volatile LAS unsigned*)(lds + MISC_OFF);
    if (threadIdx.x < 16) misc[threadIdx.x] = 0u;
    __syncthreads();
    XcdBarrier xbar; xbar.bar = (unsigned*)(args.ws + WS_BAR); xbar.x = 0; xbar.st = misc;
    if (hi - lo > 1) xbar = xcd_barrier_post((unsigned*)(args.ws + WS_BAR), misc);
#define PH_BEGIN(k) if (lo <= (k) && (k) < hi) { { int t = threadIdx.x; asm volatile("" : "+v"(t)); F.tid = t; F.lane = t & 63; F.wave = __builtin_amdgcn_readfirstlane(t >> 6); \
          const __attribute__((address_space(4))) Args* ap = (const __attribute__((address_space(4))) Args*)__builtin_amdgcn_kernarg_segment_ptr(); \
          asm volatile("" : "+s"(ap)); F.ap = ap; F.ws = ap->ws; F.out = ap->out; } const float* mod = (const float*)(F.ws + WS_CTL); (void)mod;
#define PH_END(k) if ((k) + 1 < hi) xcd_barrier(xbar); }
#define REP(k) for (int rep_ = 0; (F.rep = rep_) < PH_REP[k]; ++rep_)
    PH_BEGIN(PH_PREP) REP(PH_PREP) { phase_gemv(F, lds); phase_prep(F, lds); } PH_END(PH_PREP)
    PH_BEGIN(PH_NORM_A0) REP(PH_NORM_A0) { norm_rows(F, FIN(0), FIN(2), MR, FIN(6), mod, mod + DM, mod + 2 * 12288, mod + 2 * 12288 + DM, (bf16_t*)(F.ws + WS_H)); } PH_END(PH_NORM_A0)
    PH_BEGIN(PH_G_IN0) REP(PH_G_IN0) { gemm_phase(F, lds, PH_G_IN0); } PH_END(PH_G_IN0)
    PH_BEGIN(PH_QKPOOL) REP(PH_QKPOOL) { phase_qkpool(F); } PH_END(PH_QKPOOL)
    PH_BEGIN(PH_ATTN) REP(PH_ATTN) { phase_attn(F, lds); } PH_END(PH_ATTN)
    PH_BEGIN(PH_G_OUT0) REP(PH_G_OUT0) { gemm_phase(F, lds, PH_G_OUT0); } PH_END(PH_G_OUT0)
    PH_BEGIN(PH_NORM_B0) REP(PH_NORM_B0) { norm_rows(F, F.out, F.out, NT, FIN(7), mod + 3 * DM, mod + 4 * DM, mod, mod, (bf16_t*)(F.ws + WS_H)); } PH_END(PH_NORM_B0)
    PH_BEGIN(PH_G_UP0) REP(PH_G_UP0) { gemm_phase(F, lds, PH_G_UP0); } PH_END(PH_G_UP0)
    PH_BEGIN(PH_G_DN0) REP(PH_G_DN0) { gemm_phase(F, lds, PH_G_DN0); } PH_END(PH_G_DN0)
    PH_BEGIN(PH_NORM_A1) REP(PH_NORM_A1) { norm_rows(F, F.out, F.out, NT, FIN(6) + DM, mod + 12288, mod + 12288 + DM, mod, mod, (bf16_t*)(F.ws + WS_H)); } PH_END(PH_NORM_A1)
    PH_BEGIN(PH_G_IN1) REP(PH_G_IN1) { gemm_phase(F, lds, PH_G_IN1); } PH_END(PH_G_IN1)
    PH_BEGIN(PH_G_F1) REP(PH_G_F1) { gemm_phase(F, lds, PH_G_F1); phase_vtn(F, lds); } PH_END(PH_G_F1)
    PH_BEGIN(PH_G_S1) REP(PH_G_S1) { gemm_phase(F, lds, PH_G_S1); } PH_END(PH_G_S1)
    PH_BEGIN(PH_G_S2) REP(PH_G_S2) { gemm_phase(F, lds, PH_G_S2); } PH_END(PH_G_S2)
    PH_BEGIN(PH_G_OUT1) REP(PH_G_OUT1) { gemm_phase(F, lds, PH_G_OUT1); } PH_END(PH_G_OUT1)
    PH_BEGIN(PH_NORM_B1) REP(PH_NORM_B1) { norm_rows(F, F.out, F.out, NT, FIN(7) + DM, mod + 12288 + 3 * DM, mod + 12288 + 4 * DM, mod, mod, (bf16_t*)(F.ws + WS_H)); } PH_END(PH_NORM_B1)
    PH_BEGIN(PH_G_UP1) REP(PH_G_UP1) { gemm_phase(F, lds, PH_G_UP1); } PH_END(PH_G_UP1)
    PH_BEGIN(PH_G_DN1) REP(PH_G_DN1) { gemm_phase(F, lds, PH_G_DN1); } PH_END(PH_G_DN1)
#undef PH_BEGIN
#undef PH_END
}

#ifndef MK_SPLIT
#define MK_SPLIT 0
#endif
extern "C" void kernel_launch(void* const* d_in, const int* in_sizes, int n_in, void* d_out, int out_size, void* d_ws, size_t ws_size, hipStream_t stream) {
    static int grid = 0;
    if (grid == 0) {
        if (n_in != 25 || out_size != NT * DM || ws_size < WS_END) { fprintf(stderr, "kernel_launch: unexpected problem (n_in %d out %d ws %zu)\n", n_in, out_size, ws_size); grid = -1; return; }
        int dev = 0, cus = 0, per_cu = 0;
        hipGetDevice(&dev); hipDeviceGetAttribute(&cus, hipDeviceAttributeMultiprocessorCount, dev);
        hipFuncSetAttribute((const void*)fwd_mega, hipFuncAttributeMaxDynamicSharedMemorySize, LDS_BYTES);
        hipOccupancyMaxActiveBlocksPerMultiprocessor(&per_cu, (const void*)fwd_mega, 512, LDS_BYTES);
        if (per_cu < 1) { fprintf(stderr, "kernel_launch: occupancy query says %d blocks per CU\n", per_cu); per_cu = 1; }
        grid = cus * 1;
        (void)hipGetLastError();
    }
    if (grid < 0) return;
    hipMemsetAsync((char*)d_ws + WS_BAR, 0, XCD_BAR_WORDS * 4, stream);
    Args a{};
    for (int i = 0; i < 25; ++i) a.in[i] = (const float*)d_in[i];
    a.out = (float*)d_out; a.ws = (unsigned char*)d_ws;
#if MK_SPLIT
    for (int ph = 0; ph < PH_COUNT; ++ph) {
        a.ph_lo = ph; a.ph_hi = ph + 1;
        hipLaunchKernelGGL(fwd_mega, dim3(grid), dim3(512), LDS_BYTES, stream, a);
    }
#else
    a.ph_lo = 0; a.ph_hi = PH_COUNT;
    void* kargs[] = {&a};
    hipError_t e = hipLaunchCooperativeKernel((const void*)fwd_mega, dim3(grid), dim3(512), kargs, LDS_BYTES, stream);
    if (e != hipSuccess) fprintf(stderr, "cooperative launch failed: %s (grid %d)\n", hipGetErrorString(e), grid);
#endif
}
```
